# Optimizing an MI355X kernel written in HIP

```python
import math
import jax, jax.numpy as jnp
from jax import lax
import numpy as np

D_MODEL = 2048
BATCH = 4
SEQ = 4096
DEPTH = 1

D_MIX = D_MODEL
D_ATTN = D_MIX // 2
D_SSM = D_MIX - D_ATTN
HEAD_DIM = 64
N_Q_HEADS = D_ATTN // HEAD_DIM
N_KV_HEADS = 2
Q_PER_KV = N_Q_HEADS // N_KV_HEADS
D_KV = N_KV_HEADS * HEAD_DIM
WINDOW = 128
BLOCK = 128
NUM_BUCKETS = 32
MAX_DISTANCE = 128
SSM_GROUP = 16
N_SSM_GROUPS = D_SSM // SSM_GROUP
SSM_STATE = 64
DT_MIN = 0.001
DT_MAX = 0.1
N_EXPERT_GROUPS = 4
EXPERTS_PER_GROUP = 8
TOP_K = 2
D_FF_EXPERT = 512

D_IN_PROJ = D_ATTN + 2 * D_KV + D_SSM
EPS = 1e-6
NEG_INF = -1e30

kernel_name = "hymba_swa_s5_hiermoe_block"


def rmsnorm(x, g):
    x32 = x.astype(jnp.float32)
    y = x32 * lax.rsqrt(jnp.mean(x32 * x32, axis=-1, keepdims=True) + EPS)
    return (y * g.astype(jnp.float32)).astype(x.dtype)


def t5_bucket(n):
    max_exact = NUM_BUCKETS // 2
    nf = jnp.maximum(n, 1).astype(jnp.float32)
    large = max_exact + (jnp.log(nf / max_exact) / math.log(MAX_DISTANCE / max_exact)
                         * (NUM_BUCKETS - max_exact)).astype(jnp.int32)
    large = jnp.minimum(large, NUM_BUCKETS - 1)
    return jnp.where(n < max_exact, n, large)


def band_offsets():
    i = jnp.arange(BLOCK)[:, None]
    j = jnp.arange(2 * BLOCK)[None, :]
    return i + BLOCK - j, j


def t5_block_bias(table):
    dist, _ = band_offsets()
    bias = table[t5_bucket(jnp.maximum(dist, 0))]
    return jnp.transpose(bias, (2, 0, 1)).astype(jnp.float32)


def sliding_window_attention(q, k, v, sinks, bias_table):
    bsz, seq = q.shape[0], q.shape[1]
    nb = seq // BLOCK
    qb = q.reshape(bsz, nb, BLOCK, N_KV_HEADS, Q_PER_KV, HEAD_DIM)

    def band(t):
        prev = jnp.pad(t, ((0, 0), (BLOCK, 0), (0, 0), (0, 0)))[:, :seq]
        prev = prev.reshape(bsz, nb, BLOCK, N_KV_HEADS, HEAD_DIM)
        cur = t.reshape(bsz, nb, BLOCK, N_KV_HEADS, HEAD_DIM)
        return jnp.concatenate([prev, cur], axis=2)

    kb, vb = band(k), band(v)
    scores = jnp.einsum('bnqkgd,bnskd->bnkgqs', qb, kb,
                        preferred_element_type=jnp.float32) * (HEAD_DIM ** -0.5)
    bias = t5_block_bias(bias_table).reshape(N_KV_HEADS, Q_PER_KV, BLOCK, 2 * BLOCK)
    scores = scores + bias
    dist, j = band_offsets()
    kpos = jnp.arange(nb)[:, None, None] * BLOCK - BLOCK + j[None]
    valid = (dist >= 0)[None] & (dist < WINDOW)[None] & (kpos >= 0)
    scores = jnp.where(valid[None, :, None, None], scores, NEG_INF)
    sink = jnp.broadcast_to(sinks.astype(jnp.float32).reshape(N_KV_HEADS, Q_PER_KV, 1, 1),
                            scores.shape[:-1] + (1,))
    probs = jax.nn.softmax(jnp.concatenate([scores, sink], axis=-1), axis=-1)[..., :-1]
    out = jnp.einsum('bnkgqs,bnskd->bnqkgd', probs.astype(vb.dtype), vb)
    return out.reshape(bsz, seq, N_Q_HEADS * HEAD_DIM)


def complex_affine_combine(c1, c2):
    a1r, a1i, b1r, b1i = c1
    a2r, a2i, b2r, b2i = c2
    return (a2r * a1r - a2i * a1i,
            a2r * a1i + a2i * a1r,
            a2r * b1r - a2i * b1i + b2r,
            a2r * b1i + a2i * b1r + b2i)


def s5_mixer(u, lam_re, lam_im, log_dt, b_re, b_im, c_re, c_im, d_skip, w_glu, b_glu):
    f32 = jnp.float32
    bsz, seq = u.shape[0], u.shape[1]
    ug = u.astype(f32).reshape(bsz, seq, N_SSM_GROUPS, SSM_GROUP)
    dt = jnp.exp(log_dt.astype(f32))[:, None]
    lr, li = lam_re.astype(f32), lam_im.astype(f32)
    mag = jnp.exp(lr * dt)
    ar, ai = mag * jnp.cos(li * dt), mag * jnp.sin(li * dt)
    den = lr * lr + li * li
    cr = ((ar - 1.0) * lr + ai * li) / den
    ci = (ai * lr - (ar - 1.0) * li) / den
    bu_r = jnp.einsum('blgh,gph->blgp', ug, b_re.astype(f32))
    bu_i = jnp.einsum('blgh,gph->blgp', ug, b_im.astype(f32))
    br = cr * bu_r - ci * bu_i
    bi = cr * bu_i + ci * bu_r
    a_r = jnp.broadcast_to(ar, br.shape)
    a_i = jnp.broadcast_to(ai, br.shape)
    _, _, xr, xi = lax.associative_scan(complex_affine_combine, (a_r, a_i, br, bi), axis=1)
    y = (jnp.einsum('ghp,blgp->blgh', c_re.astype(f32), xr)
         - jnp.einsum('ghp,blgp->blgh', c_im.astype(f32), xi)
         + d_skip.astype(f32) * ug)
    y = jax.nn.gelu(y.reshape(bsz, seq, D_SSM))
    y = y * jax.nn.sigmoid(y @ w_glu.astype(f32) + b_glu.astype(f32))
    return y.astype(u.dtype)


def hierarchical_moe(h, w_router_group, b_router_group, w_router_expert, b_router_expert,
                     w_gate, w_up, w_down):
    f32 = jnp.float32
    bsz, seq, d = h.shape
    t = h.reshape(bsz * seq, d)
    g_probs = jax.nn.softmax((t @ w_router_group).astype(f32) + b_router_group.astype(f32), axis=-1)
    g_idx = jnp.argmax(g_probs, axis=-1)
    g_gate = jnp.take_along_axis(g_probs, g_idx[:, None], axis=-1)
    e_logits = (jnp.einsum('td,gde->tge', t, w_router_expert).astype(f32)
                + b_router_expert.astype(f32))
    e_sel = jnp.take_along_axis(e_logits, g_idx[:, None, None], axis=1)[:, 0]
    top_vals, top_idx = lax.top_k(e_sel, TOP_K)
    top_w = jax.nn.softmax(top_vals, axis=-1) * g_gate
    expert_w = jnp.sum(jax.nn.one_hot(top_idx, EXPERTS_PER_GROUP, dtype=f32)
                       * top_w[..., None], axis=1)
    group_mask = jax.nn.one_hot(g_idx, N_EXPERT_GROUPS, dtype=f32)
    out = jnp.zeros((bsz * seq, d), f32)
    for g in range(N_EXPERT_GROUPS):
        gate = jnp.einsum('td,edf->tef', t, w_gate[g])
        up = jnp.einsum('td,edf->tef', t, w_up[g])
        wgt = (expert_w * group_mask[:, g:g + 1])[..., None]
        hid = (jax.nn.silu(gate) * up).astype(f32) * wgt
        out = out + jnp.einsum('tef,efd->td', hid.astype(t.dtype), w_down[g],
                               preferred_element_type=f32)
    return out.reshape(bsz, seq, d).astype(h.dtype)


def hybrid_layer(x, rel_bias_table, g_norm_mix, w_in, attn_sinks, lam_re, lam_im, log_dt,
                 ssm_b_re, ssm_b_im, ssm_c_re, ssm_c_im, ssm_d, w_glu, b_glu,
                 g_attn_out, g_ssm_out, w_out, g_norm_ffn, w_router_group, b_router_group,
                 w_router_expert, b_router_expert, w_gate, w_up, w_down):
    bsz, seq, _ = x.shape
    h = rmsnorm(x, g_norm_mix)
    proj = h @ w_in
    q, k, v, u = jnp.split(proj, [D_ATTN, D_ATTN + D_KV, D_ATTN + 2 * D_KV], axis=-1)
    q = q.reshape(bsz, seq, N_Q_HEADS, HEAD_DIM)
    k = k.reshape(bsz, seq, N_KV_HEADS, HEAD_DIM)
    v = v.reshape(bsz, seq, N_KV_HEADS, HEAD_DIM)
    attn = sliding_window_attention(q, k, v, attn_sinks, rel_bias_table)
    ssm = s5_mixer(u, lam_re, lam_im, log_dt, ssm_b_re, ssm_b_im, ssm_c_re, ssm_c_im,
                   ssm_d, w_glu, b_glu)
    mixed = jnp.concatenate([rmsnorm(attn, g_attn_out), rmsnorm(ssm, g_ssm_out)], axis=-1)
    x = x + mixed @ w_out
    x = x + hierarchical_moe(rmsnorm(x, g_norm_ffn), w_router_group, b_router_group,
                             w_router_expert, b_router_expert, w_gate, w_up, w_down)
    return x


def setup_inputs(seed: int = 0) -> dict:
    key = jax.random.key(seed)
    ks = jax.random.split(key, 32)
    f32 = jnp.float32
    nrm = lambda k, shape, scale: jax.random.normal(k, shape, f32) * scale
    L = DEPTH
    G, P, HG = N_SSM_GROUPS, SSM_STATE, SSM_GROUP
    NG, E, F = N_EXPERT_GROUPS, EXPERTS_PER_GROUP, D_FF_EXPERT
    lam_im = (jnp.pi * jnp.arange(P, dtype=f32))[None, None, :] + nrm(ks[6], (L, G, P), 0.01)
    log_dt = jax.random.uniform(ks[7], (L, G), f32, math.log(DT_MIN), math.log(DT_MAX))
    return {
        "x": nrm(ks[0], (BATCH, SEQ, D_MODEL), 1.0),
        "rel_bias_table": nrm(ks[1], (NUM_BUCKETS, N_Q_HEADS), 0.5),
        "g_norm_mix": 1.0 + nrm(ks[2], (L, D_MODEL), 0.02),
        "w_in": nrm(ks[3], (L, D_MODEL, D_IN_PROJ), D_MODEL ** -0.5),
        "attn_sinks": nrm(ks[4], (L, N_Q_HEADS), 0.5),
        "lam_re": -0.5 + nrm(ks[5], (L, G, P), 0.01),
        "lam_im": lam_im,
        "log_dt": log_dt,
        "ssm_b_re": nrm(ks[8], (L, G, P, HG), (2.0 * HG) ** -0.5),
        "ssm_b_im": nrm(ks[9], (L, G, P, HG), (2.0 * HG) ** -0.5),
        "ssm_c_re": nrm(ks[10], (L, G, HG, P), (2.0 * P) ** -0.5),
        "ssm_c_im": nrm(ks[11], (L, G, HG, P), (2.0 * P) ** -0.5),
        "ssm_d": nrm(ks[12], (L, G, HG), 1.0),
        "w_glu": nrm(ks[13], (L, D_SSM, D_SSM), D_SSM ** -0.5),
        "b_glu": nrm(ks[14], (L, D_SSM), 0.02),
        "g_attn_out": 1.0 + nrm(ks[15], (L, D_ATTN), 0.02),
        "g_ssm_out": 1.0 + nrm(ks[16], (L, D_SSM), 0.02),
        "w_out": nrm(ks[17], (L, D_MIX, D_MODEL), D_MIX ** -0.5),
        "g_norm_ffn": 1.0 + nrm(ks[18], (L, D_MODEL), 0.02),
        "w_router_group": nrm(ks[19], (L, D_MODEL, NG), D_MODEL ** -0.5),
        "b_router_group": nrm(ks[20], (L, NG), 0.01),
        "w_router_expert": nrm(ks[21], (L, NG, D_MODEL, E), D_MODEL ** -0.5),
        "b_router_expert": nrm(ks[22], (L, NG, E), 0.01),
        "w_gate": nrm(ks[23], (L, NG, E, D_MODEL, F), D_MODEL ** -0.5),
        "w_up": nrm(ks[24], (L, NG, E, D_MODEL, F), D_MODEL ** -0.5),
        "w_down": nrm(ks[25], (L, NG, E, F, D_MODEL), F ** -0.5),
        "g_final": 1.0 + nrm(ks[26], (D_MODEL,), 0.02),
    }


def reference(x, rel_bias_table, g_norm_mix, w_in, attn_sinks, lam_re, lam_im, log_dt,
              ssm_b_re, ssm_b_im, ssm_c_re, ssm_c_im, ssm_d, w_glu, b_glu,
              g_attn_out, g_ssm_out, w_out, g_norm_ffn, w_router_group, b_router_group,
              w_router_expert, b_router_expert, w_gate, w_up, w_down, g_final):
    for l in range(DEPTH):
        x = hybrid_layer(x, rel_bias_table, g_norm_mix[l], w_in[l], attn_sinks[l],
                         lam_re[l], lam_im[l], log_dt[l], ssm_b_re[l], ssm_b_im[l],
                         ssm_c_re[l], ssm_c_im[l], ssm_d[l], w_glu[l], b_glu[l],
                         g_attn_out[l], g_ssm_out[l], w_out[l], g_norm_ffn[l],
                         w_router_group[l], b_router_group[l], w_router_expert[l],
                         b_router_expert[l], w_gate[l], w_up[l], w_down[l])
    return rmsnorm(x, g_final)
```

```cpp
#include <hip/hip_runtime.h>
#include <cstdio>
#include <cstdint>
namespace pg8 {
#define PG8_LAS __attribute__((address_space(3)))
typedef unsigned short bf16_t;
typedef short bf16x8 __attribute__((ext_vector_type(8)));
typedef float f32x4 __attribute__((ext_vector_type(4)));
typedef float f32x2 __attribute__((ext_vector_type(2)));
typedef unsigned u32x4 __attribute__((ext_vector_type(4)));
typedef unsigned u32x2 __attribute__((ext_vector_type(2)));
constexpr int BM = 256, BK = 64, HALF = 128, HTB = HALF * BK * 2  , STAGE_BYTES = 8 * HTB, NXCD = 8, WGM = 8;

__host__ __device__ __forceinline__ int lds_byte(int r, int c) { const int st = (r >> 4) * 2 + (c >> 5), rr = r & 15, cc = c & 31, ob = rr * 64 + cc * 2; return st * 1024 + (ob ^ (((ob >> 9) & 1) << 5)); }
__host__ __device__ __forceinline__ void stage_rc(int b, int& R, int& C) { const int st = b / 1024, sb = b % 1024, swz = sb ^ (((sb >> 9) & 1) << 5); R = (st >> 1) * 16 + swz / 64; C = (st & 1) * 32 + (swz % 64) / 2; }
__host__ __device__ __forceinline__ int perm32(int rho) { const int n = rho >> 4, i = rho & 15; return 8 * (i >> 2) + 4 * n + (i & 3); }

struct Unit { int pm, pn; };
struct Gemm { const bf16_t* A; const bf16_t* Bt; int K, lda, ldb; };

struct StaticOrder {
    int nM, nN, nwg, G, c;
    __host__ __device__ void init(int M, int N, int G_, int c_) { nM = M / BM; nN = N / BM; nwg = nM * nN; G = G_; c = c_; }
    __host__ __device__ bool next(int i, Unit& u) const {
        const long L = (long)i * G + c; if (L >= nwg) return false;
        int wgid = (int)L; { const int q = nwg / NXCD, r = nwg % NXCD, xcd = wgid % NXCD, off = wgid / NXCD; wgid = (xcd < r ? xcd * (q + 1) : r * (q + 1) + (xcd - r) * q) + off; }
        const int nig = WGM * nN, gid = wgid / nig, fm = gid * WGM, gsz = (nM - fm) < WGM ? (nM - fm) : WGM;
        u.pm = fm + ((wgid % nig) % gsz); u.pn = (wgid % nig) / gsz; return true;
    }
    __device__ __forceinline__ void a_ready(const Unit&) const {}
    __device__ __forceinline__ void done(const Unit&) const {}
};
struct DiagOrder {
    int G, c;
    __device__ bool next(int i, Unit& u) const { const int L = i * G + c; if (L >= 256) return false; u.pm = L; u.pn = L >> 2; return true; }
    __device__ __forceinline__ void a_ready(const Unit&) const {}
    __device__ __forceinline__ void done(const Unit&) const {}
};
struct MoeOrder {
    const PG8_LAS int* tb; int ntn, G, c;
    __device__ bool next(int i, Unit& u) const {
        const int L = i * G + c, NT = tb[32]; if (L >= NT * ntn) return false;
        const int tt = L / ntn, nt = L - tt * ntn; int E = 0;
#pragma unroll
        for (int e = 1; e < 32; ++e) E += (tt >= tb[e]) ? 1 : 0;
        u.pm = tt; u.pn = __builtin_amdgcn_readfirstlane(E * ntn + nt); return true;
    }
    __device__ __forceinline__ void a_ready(const Unit&) const {}
    __device__ __forceinline__ void done(const Unit&) const {}
};

__device__ __forceinline__ unsigned cvt_pk_bf16(float lo, float hi) { unsigned r; asm volatile("v_cvt_pk_bf16_f32 %0, %1, %2" : "=v"(r) : "v"(lo), "v"(hi)); return r; }
__device__ __forceinline__ u32x4 pack8(const f32x4 a, const f32x4 b) { u32x4 w; w.x = cvt_pk_bf16(a[0], a[1]); w.y = cvt_pk_bf16(a[2], a[3]); w.z = cvt_pk_bf16(b[0], b[1]); w.w = cvt_pk_bf16(b[2], b[3]); return w; }
__device__ __forceinline__ float bf_lo(unsigned w) { return __uint_as_float(w << 16); }
__device__ __forceinline__ float bf_hi(unsigned w) { return __uint_as_float(w & 0xffff0000u); }
__device__ __forceinline__ float sigmoidf_(float v) { return __builtin_amdgcn_rcpf(1.0f + __builtin_amdgcn_exp2f(-1.4426950408889634f * v)); }
__device__ __forceinline__ float gelu_tanh_(float v) { const float z = v + 0.044715f * v * v * v; return v * __builtin_amdgcn_rcpf(1.0f + __builtin_amdgcn_exp2f(-2.3022081982f * z)); }

constexpr float QSCALE = 0.125f * 1.4426950408889634f;

struct EpiInProj {
    static constexpr bool PERM = true, AFTER_DRAIN = false;
    bf16_t* Q; bf16_t* KV; bf16_t* UX;
    __device__ __forceinline__ void operator()(const f32x4 (&acc)[2][2][4][2], const Unit& u, int wr, int wc, int fr, int fq) const {
        const int row0 = u.pm * BM + wr * 64 + fr, cw = wc * 32 + 8 * fq;
#pragma unroll
        for (int ai = 0; ai < 2; ++ai)
#pragma unroll
            for (int m = 0; m < 4; ++m) { const int row = row0 + ai * HALF + m * 16;
#pragma unroll
                for (int bj = 0; bj < 2; ++bj) { f32x4 v0 = acc[ai][bj][m][0], v1 = acc[ai][bj][m][1]; const int ct = bj * HALF + cw;
                    if (u.pn < 4) { v0 = v0 * QSCALE; v1 = v1 * QSCALE; *(u32x4*)(Q + (size_t)row * 1024 + u.pn * 256 + ct) = pack8(v0, v1); }
                    else if (u.pn == 4) { *(u32x4*)(KV + (size_t)row * 256 + ct) = pack8(v0, v1); }
                    else { const int ch = (u.pn - 5) * 256 + ct, g = ch >> 4, hi0 = ch & 15;
                        *(u32x4*)(UX + ((size_t)(g * 1024 + (row >> 4)) * 384 + (row & 15) * 16 + hi0)) = pack8(v0, v1); } } }
    }
};
struct EpiS {
    static constexpr bool PERM = false, AFTER_DRAIN = false;
    float* S;
    __device__ __forceinline__ void operator()(const f32x4 (&acc)[2][2][4][2], const Unit& u, int wr, int wc, int fr, int fq) const {
        const int row0 = u.pm * BM + wr * 64 + fr, col0 = wc * 32 + 4 * fq;
#pragma unroll
        for (int ai = 0; ai < 2; ++ai)
#pragma unroll
            for (int m = 0; m < 4; ++m) { float* rowp = S + (size_t)(row0 + ai * HALF + m * 16) * 128 + col0;
#pragma unroll
                for (int n = 0; n < 2; ++n) *(f32x4*)(rowp + n * 16) = acc[ai][0][m][n]; }
    }
};
struct EpiY {
    static constexpr bool PERM = true, AFTER_DRAIN = false;
    bf16_t* YG;
    __device__ __forceinline__ void operator()(const f32x4 (&acc)[2][2][4][2], const Unit& u, int wr, int wc, int fr, int fq) const {
        const int g = u.pm >> 2, s0 = (u.pm & 3) * 256 + wr * 64 + fr, cw = wc * 32 + 8 * fq;
#pragma unroll
        for (int ai = 0; ai < 2; ++ai)
#pragma unroll
            for (int m = 0; m < 4; ++m) { const int stream = s0 + ai * HALF + m * 16;
#pragma unroll
                for (int bj = 0; bj < 2; ++bj) { const int n = bj * HALF + cw, tau = n >> 4, ho0 = n & 15; f32x4 v0 = acc[ai][bj][m][0], v1 = acc[ai][bj][m][1];
#pragma unroll
                    for (int e = 0; e < 4; ++e) { v0[e] = gelu_tanh_(v0[e]); v1[e] = gelu_tanh_(v1[e]); }
                    *(u32x4*)(YG + (size_t)(stream * 16 + tau) * 1024 + g * 16 + ho0) = pack8(v0, v1); } }
    }
};
struct EpiGLU {
    static constexpr bool PERM = true, AFTER_DRAIN = false;
    const bf16_t* YG; const float* bias; bf16_t* SG; float* RS;
    __device__ __forceinline__ void operator()(const f32x4 (&acc)[2][2][4][2], const Unit& u, int wr, int wc, int fr, int fq) const {
        const int row0 = u.pm * BM + wr * 64 + fr, col0 = u.pn * BM + wc * 32 + 8 * fq;
        f32x4 bv[2][2];
#pragma unroll
        for (int bj = 0; bj < 2; ++bj)
#pragma unroll
            for (int n = 0; n < 2; ++n) bv[bj][n] = *(const f32x4*)(bias + col0 + bj * HALF + 4 * n);
#pragma unroll
        for (int ai = 0; ai < 2; ++ai)
#pragma unroll
            for (int m = 0; m < 4; ++m) { const int row = row0 + ai * HALF + m * 16; float ss = 0.f;
#pragma unroll
                for (int bj = 0; bj < 2; ++bj) { const size_t off = (size_t)row * 1024 + col0 + bj * HALF; const u32x4 yw = *(const u32x4*)(YG + off);
                    const f32x4 a0 = acc[ai][bj][m][0] + bv[bj][0], a1 = acc[ai][bj][m][1] + bv[bj][1]; f32x4 o0, o1;
                    o0[0] = bf_lo(yw.x) * sigmoidf_(a0[0]); o0[1] = bf_hi(yw.x) * sigmoidf_(a0[1]); o0[2] = bf_lo(yw.y) * sigmoidf_(a0[2]); o0[3] = bf_hi(yw.y) * sigmoidf_(a0[3]);
                    o1[0] = bf_lo(yw.z) * sigmoidf_(a1[0]); o1[1] = bf_hi(yw.z) * sigmoidf_(a1[1]); o1[2] = bf_lo(yw.w) * sigmoidf_(a1[2]); o1[3] = bf_hi(yw.w) * sigmoidf_(a1[3]);
                    ss += (o0[0] * o0[0] + o0[1] * o0[1]) + (o0[2] * o0[2] + o0[3] * o0[3]) + (o1[0] * o1[0] + o1[1] * o1[1]) + (o1[2] * o1[2] + o1[3] * o1[3]);
                    *(u32x4*)(SG + off) = pack8(o0, o1); }
                ss += __shfl_xor(ss, 16); ss += __shfl_xor(ss, 32);
                if (fq == 0) RS[(size_t)row * 16 + u.pn * 4 + wc] = ss; }
    }
};
struct EpiOut {
    static constexpr bool PERM = false, AFTER_DRAIN = false;
    const float* X; float* O;
    __device__ __forceinline__ void operator()(const f32x4 (&acc)[2][2][4][2], const Unit& u, int wr, int wc, int fr, int fq) const {
        const int row0 = u.pm * BM + wr * 64 + fr, col0 = u.pn * BM + wc * 32 + 4 * fq;
#pragma unroll
        for (int ai = 0; ai < 2; ++ai)
#pragma unroll
            for (int m = 0; m < 4; ++m) { const size_t off = (size_t)(row0 + ai * HALF + m * 16) * 2048 + col0;
#pragma unroll
                for (int bj = 0; bj < 2; ++bj)
#pragma unroll
                    for (int n = 0; n < 2; ++n) { const size_t o = off + bj * HALF + n * 16; *(f32x4*)(O + o) = *(const f32x4*)(X + o) + acc[ai][bj][m][n]; } }
    }
};
struct EpiSwiGLU {
    static constexpr bool PERM = true, AFTER_DRAIN = false;
    const float* slot_rstd; const float* slot_w; bf16_t* HID;
    __device__ __forceinline__ void operator()(const f32x4 (&acc)[2][2][4][2], const Unit& u, int wr, int wc, int fr, int fq) const {
        const int row0 = u.pm * BM + wr * 64 + fr, col0 = (u.pn & 3) * 128 + wc * 32 + 8 * fq;
#pragma unroll
        for (int ai = 0; ai < 2; ++ai)
#pragma unroll
            for (int m = 0; m < 4; ++m) { const int slot = row0 + ai * HALF + m * 16; const float rs = slot_rstd[slot], w = slot_w[slot]; f32x4 o[2];
#pragma unroll
                for (int n = 0; n < 2; ++n)
#pragma unroll
                    for (int e = 0; e < 4; ++e) { const float gt = acc[ai][0][m][n][e] * rs, up = acc[ai][1][m][n][e] * rs; o[n][e] = gt * sigmoidf_(gt) * up * w; }
                *(u32x4*)(HID + (size_t)slot * 512 + col0) = pack8(o[0], o[1]); }
    }
};
struct EpiDown {
    static constexpr bool PERM = true, AFTER_DRAIN = false;
    bf16_t* O;
    __device__ __forceinline__ void operator()(const f32x4 (&acc)[2][2][4][2], const Unit& u, int wr, int wc, int fr, int fq) const {
        const int row0 = u.pm * BM + wr * 64 + fr, col0 = (u.pn & 7) * 256 + wc * 32 + 8 * fq;
#pragma unroll
        for (int ai = 0; ai < 2; ++ai)
#pragma unroll
            for (int m = 0; m < 4; ++m) { bf16_t* rowp = O + (size_t)(row0 + ai * HALF + m * 16) * 2048 + col0;
#pragma unroll
                for (int bj = 0; bj < 2; ++bj) *(u32x4*)(rowp + bj * HALF) = pack8(acc[ai][bj][m][0], acc[ai][bj][m][1]); }
    }
};

template <class Epi, class Sched, bool ALIGN_EPI = false, bool SP2 = false>
__device__ __forceinline__ void gemm_phase(PG8_LAS unsigned char* lds, const Gemm g, const Sched& S, const Epi& E) {
    int tid_ = threadIdx.x; asm volatile("" : "+v"(tid_));
    const int tid = tid_, wid = __builtin_amdgcn_readfirstlane(tid >> 6), lane = tid & 63, wr = wid >> 2, wc = wid & 3, fr = lane & 15, fq = lane >> 4;
    const int K = g.K, nt = K / BK;
    unsigned voffA[2], voffB[2];
#pragma unroll
    for (int i = 0; i < 2; ++i) { int R, C; stage_rc(tid * 16 + i * 8192, R, C); const int Rb = Epi::PERM ? ((R & ~31) + perm32(R & 31)) : R;
        voffA[i] = (unsigned)(R * g.lda + C) * 2u; voffB[i] = (unsigned)(Rb * g.ldb + C) * 2u; }
    const size_t kstep = (size_t)(BK * 2);
    const size_t hstepA = (size_t)HALF * g.lda * 2, hstepB = (size_t)HALF * g.ldb * 2;
    const size_t tstepA = 2 * hstepA, tstepB = 2 * hstepB;
    const unsigned ldsw = (unsigned)wid * 1024u;
    const int aoff = lds_byte(wr * 64 + fr, fq * 8), boff = lds_byte(wc * 32 + fr, fq * 8);
#define PG8_SA(b, h) (((b) * 2 + (h)) * HTB)
#define PG8_SB(b, h) ((4 + (b) * 2 + (h)) * HTB)
#define PG8_STAGE(bufoff, gbase, voff) do { _Pragma("unroll") for (int _i = 0; _i < 2; ++_i) \
        __builtin_amdgcn_global_load_lds((const unsigned*)((const char*)(gbase) + (voff)[_i]), (PG8_LAS unsigned*)(lds + (bufoff) + ldsw + _i * 8192), 16, 0, 0); } while (0)
#define PG8_LDA(dst, b, h) do { _Pragma("unroll") for (int m = 0; m < 4; ++m) _Pragma("unroll") for (int k = 0; k < 2; ++k) dst[m][k] = *(const PG8_LAS bf16x8*)(lds + PG8_SA(b, h) + aoff + m * 2048 + k * 1024); } while (0)
#define PG8_LDB(dst, b, h) do { _Pragma("unroll") for (int n = 0; n < 2; ++n) _Pragma("unroll") for (int k = 0; k < 2; ++k) dst[n][k] = *(const PG8_LAS bf16x8*)(lds + PG8_SB(b, h) + boff + n * 2048 + k * 1024); } while (0)
#define PG8_MMA(ai, bj, At, Bt) do { __builtin_amdgcn_s_setprio(1); _Pragma("unroll") for (int m = 0; m < 4; ++m) _Pragma("unroll") for (int n = 0; n < 2; ++n) _Pragma("unroll") for (int k = 0; k < 2; ++k) \
        acc[ai][bj][m][n] = __builtin_amdgcn_mfma_f32_16x16x32_bf16(Bt[n][k], At[m][k], acc[ai][bj][m][n], 0, 0, 0); __builtin_amdgcn_s_setprio(0); } while (0)
#define PG8_WAIT_V(n) asm volatile("s_waitcnt vmcnt(" #n ")" ::: "memory")
#define PG8_WAIT_L(n) asm volatile("s_waitcnt lgkmcnt(" #n ")" ::: "memory")
#define PG8_BAR __builtin_amdgcn_s_barrier()
#define PG8_SCHED __builtin_amdgcn_sched_barrier(0)
    Unit cur, nxt; int ui = 0;
    if (!S.next(0, cur)) return;
    f32x4 acc[2][2][4][2];
#pragma unroll
    for (int a = 0; a < 2; ++a)
#pragma unroll
        for (int b = 0; b < 2; ++b)
#pragma unroll
            for (int m = 0; m < 4; ++m)
#pragma unroll
                for (int n = 0; n < 2; ++n) acc[a][b][m][n] = (f32x4){0.f, 0.f, 0.f, 0.f};
    bf16x8 At[4][2], B0[2][2], B1[2][2];
    const char* cA = (const char*)g.A + (size_t)cur.pm * tstepA; const char* cB = (const char*)g.Bt + (size_t)cur.pn * tstepB;
    S.a_ready(cur);
    if constexpr (SP2) {
        PG8_STAGE(PG8_SB(0, 0), cB, voffB); PG8_STAGE(PG8_SB(0, 1), cB + hstepB, voffB); PG8_STAGE(PG8_SA(0, 0), cA, voffA); PG8_STAGE(PG8_SA(0, 1), cA + hstepA, voffA);
        if (wr == 1) PG8_BAR;
        PG8_WAIT_V(2); PG8_BAR;
        PG8_STAGE(PG8_SB(1, 0), cB + kstep, voffB); PG8_STAGE(PG8_SA(1, 0), cA + kstep, voffA); PG8_STAGE(PG8_SB(1, 1), cB + hstepB + kstep, voffB);
        PG8_WAIT_V(6); PG8_BAR;
    } else {
        PG8_STAGE(PG8_SB(0, 0), cB, voffB); PG8_STAGE(PG8_SA(0, 0), cA, voffA); PG8_STAGE(PG8_SB(0, 1), cB + hstepB, voffB); PG8_STAGE(PG8_SA(0, 1), cA + hstepA, voffA);
        if (wr == 1) PG8_BAR;
        PG8_WAIT_V(4); PG8_BAR;
        PG8_STAGE(PG8_SB(1, 0), cB + kstep, voffB); PG8_STAGE(PG8_SA(1, 0), cA + kstep, voffA); PG8_STAGE(PG8_SB(1, 1), cB + hstepB + kstep, voffB);
        PG8_WAIT_V(6); PG8_BAR;
    }
    for (;;) {
        const bool has_next = S.next(ui + 1, nxt);
        const char* nA = has_next ? (const char*)g.A + (size_t)nxt.pm * tstepA : cA; const char* nB = has_next ? (const char*)g.Bt + (size_t)nxt.pn * tstepB : cB;
        for (int t = 0; t < nt; t += 2) {
            const bool last = (t == nt - 2);
            const char* a1 = cA + (size_t)(t + 1) * kstep;
            const char* a2 = last ? nA : cA + (size_t)(t + 2) * kstep; const char* b2 = last ? nB : cB + (size_t)(t + 2) * kstep;
            const char* a3 = a2 + kstep; const char* b3 = b2 + kstep;
            if (last && has_next) S.a_ready(nxt);
            if constexpr (SP2) {
            PG8_LDB(B0, 0, 0); PG8_LDB(B1, 0, 1); PG8_SCHED; PG8_LDA(At, 0, 0); PG8_STAGE(PG8_SA(1, 1), a1 + hstepA, voffA);
            PG8_WAIT_V(8); PG8_WAIT_L(0); PG8_BAR; PG8_MMA(0, 0, At, B0); PG8_MMA(0, 1, At, B1); PG8_BAR; PG8_SCHED;
            PG8_LDA(At, 0, 1); PG8_STAGE(PG8_SB(0, 0), b2, voffB); PG8_STAGE(PG8_SB(0, 1), b2 + hstepB, voffB); PG8_STAGE(PG8_SA(0, 0), a2, voffA);
            PG8_WAIT_V(8); PG8_WAIT_L(0); PG8_BAR; PG8_MMA(1, 0, At, B0); PG8_MMA(1, 1, At, B1); PG8_BAR; PG8_SCHED;
            PG8_LDB(B0, 1, 0); PG8_LDB(B1, 1, 1); PG8_SCHED; PG8_LDA(At, 1, 0); PG8_STAGE(PG8_SA(0, 1), a2 + hstepA, voffA);
            PG8_WAIT_V(8); PG8_WAIT_L(0); PG8_BAR; PG8_MMA(0, 0, At, B0); PG8_MMA(0, 1, At, B1); PG8_BAR; PG8_SCHED;
            PG8_LDA(At, 1, 1); PG8_STAGE(PG8_SB(1, 0), b3, voffB); PG8_STAGE(PG8_SB(1, 1), b3 + hstepB, voffB); PG8_STAGE(PG8_SA(1, 0), a3, voffA);
            PG8_WAIT_V(8); PG8_WAIT_L(0); PG8_BAR; PG8_MMA(1, 0, At, B0); PG8_MMA(1, 1, At, B1); PG8_BAR; PG8_SCHED;
            } else {
            PG8_LDB(B0, 0, 0); PG8_SCHED; PG8_LDA(At, 0, 0); PG8_STAGE(PG8_SA(1, 1), a1 + hstepA, voffA);
            PG8_WAIT_L(8); PG8_BAR; PG8_WAIT_L(0); PG8_MMA(0, 0, At, B0); PG8_BAR; PG8_SCHED;
            PG8_LDB(B1, 0, 1); PG8_STAGE(PG8_SB(0, 0), b2, voffB);
            PG8_BAR; PG8_WAIT_L(0); PG8_MMA(0, 1, At, B1); PG8_BAR;
            PG8_LDA(At, 0, 1); PG8_STAGE(PG8_SA(0, 0), a2, voffA);
            PG8_BAR; PG8_WAIT_L(0); PG8_MMA(1, 0, At, B0); PG8_BAR; PG8_SCHED;
            PG8_STAGE(PG8_SB(0, 1), b2 + hstepB, voffB);
            PG8_WAIT_V(6); PG8_BAR; PG8_MMA(1, 1, At, B1); PG8_BAR;
            PG8_LDB(B0, 1, 0); PG8_SCHED; PG8_LDA(At, 1, 0); PG8_STAGE(PG8_SA(0, 1), a2 + hstepA, voffA);
            PG8_WAIT_L(8); PG8_BAR; PG8_WAIT_L(0); PG8_MMA(0, 0, At, B0); PG8_BAR; PG8_SCHED;
            PG8_LDB(B1, 1, 1); PG8_STAGE(PG8_SB(1, 0), b3, voffB);
            PG8_BAR; PG8_WAIT_L(0); PG8_MMA(0, 1, At, B1); PG8_BAR;
            PG8_LDA(At, 1, 1); PG8_STAGE(PG8_SA(1, 0), a3, voffA);
            PG8_BAR; PG8_WAIT_L(0); PG8_MMA(1, 0, At, B0); PG8_BAR; PG8_SCHED;
            PG8_STAGE(PG8_SB(1, 1), b3 + hstepB, voffB);
            PG8_WAIT_V(6); PG8_BAR; PG8_MMA(1, 1, At, B1); PG8_BAR;
            }
        }
        if constexpr (ALIGN_EPI) { if (wr == 0) PG8_BAR; }
        if constexpr (!Epi::AFTER_DRAIN) { E(acc, cur, wr, wc, fr, fq); S.done(cur); }
        if (!has_next) break;
#pragma unroll
        for (int a = 0; a < 2; ++a)
#pragma unroll
            for (int b = 0; b < 2; ++b)
#pragma unroll
                for (int m = 0; m < 4; ++m)
#pragma unroll
                    for (int n = 0; n < 2; ++n) acc[a][b][m][n] = (f32x4){0.f, 0.f, 0.f, 0.f};
        cur = nxt; cA = nA; cB = nB; ++ui;
        if constexpr (ALIGN_EPI) { if (wr == 1) PG8_BAR; }
    }
    PG8_WAIT_V(0);
    if constexpr (!ALIGN_EPI) { if (wr == 0) PG8_BAR; }
    PG8_BAR;
    if constexpr (Epi::AFTER_DRAIN) { E.fused(acc, cur, wr, wc, fr, fq, lds, wid, lane); S.done(cur); }
#undef PG8_SA
#undef PG8_SB
#undef PG8_STAGE
#undef PG8_LDA
#undef PG8_LDB
#undef PG8_MMA
#undef PG8_WAIT_V
#undef PG8_WAIT_L
#undef PG8_BAR
#undef PG8_SCHED
}
}

constexpr int NWAVES = 8;
constexpr int M_TOK = 16384, D = 2048, SEQ = 4096, NB_ = 4;
constexpr int NPROJ = 2304, DATT = 1024, DSSM = 1024;
constexpr int NEXP = 32, DFF = 512, NRT = 48;
constexpr int MAXTILES = 160, MAXSLOTS = MAXTILES * 256;
constexpr float EPS = 1e-6f;
constexpr float LOG2E = 1.4426950408889634f;

constexpr size_t MiB = 1u << 20;
constexpr size_t WS_CTL = 0, CTL_ZERO_BYTES = 1 * MiB;
constexpr size_t WS_SMALL = 1 * MiB;
constexpr size_t SM_A16 = 0, SM_WRH = 64 * 1024, SM_WRL = SM_WRH + (size_t)NRT * D * 2;
constexpr size_t WS_WIN = 2 * MiB, WS_WGLU = 11 * MiB, WS_WOUT = 13 * MiB, WS_TE = 21 * MiB, WS_WP = 33 * MiB, WS_WGU = 41 * MiB, WS_WD = 169 * MiB;
constexpr size_t WS_XN = 233 * MiB, WS_Q = 297 * MiB, WS_KV = 329 * MiB, WS_UX = 337 * MiB;
constexpr size_t WS_S = 233 * MiB, WS_ATT = 265 * MiB;
constexpr size_t WS_RSA = 385 * MiB, WS_RSS = 386 * MiB;
constexpr size_t WS_YG = 387 * MiB, WS_SG = 419 * MiB, WS_MIX = 451 * MiB;
constexpr size_t WS_TB = 233 * MiB, WS_TG = 297 * MiB, WS_HID = 457 * MiB, WS_O = 233 * MiB, WS_ROUTE = 497 * MiB;
constexpr size_t RT_REC = 0, RT_SLOTW = 1 * MiB, RT_SLOTR = RT_SLOTW + 256 * 1024, RT_TOKSLOT = RT_SLOTR + 256 * 1024;
constexpr size_t WS_END = 515 * MiB;
static_assert(WS_TG + (size_t)MAXSLOTS * D * 2 <= WS_HID && WS_HID + (size_t)MAXSLOTS * DFF * 2 <= WS_ROUTE && WS_O + (size_t)MAXSLOTS * D * 2 <= WS_HID, "d_ws map");
constexpr int CW_TMO = 0, CW_CODE = 1;
constexpr int CW_BAR = 4096;
constexpr int CW_CNT = 16384;

constexpr int RING_OFF = 0, RING_BYTES = 131072;
constexpr int LDSCTL_OFF = RING_BYTES, MISC_OFF = LDSCTL_OFF + 320, TB_OFF = LDSCTL_OFF + 1024;
constexpr int RT_LDS_OFF = LDSCTL_OFF + 2048;
constexpr int LDS_BYTES = 147456;

#define GAS __attribute__((address_space(1)))
#define LAS __attribute__((address_space(3)))
typedef unsigned short bf16;
typedef unsigned v4u __attribute__((ext_vector_type(4)));
typedef unsigned v2u __attribute__((ext_vector_type(2)));
typedef float f32x4 __attribute__((ext_vector_type(4)));
typedef float f32x16 __attribute__((ext_vector_type(16)));
typedef short bf16x8 __attribute__((ext_vector_type(8)));
typedef GAS unsigned gu32;
#define RLX_AGENT __ATOMIC_RELAXED, __HIP_MEMORY_SCOPE_AGENT
#define LDS_WAIT() asm volatile("s_waitcnt lgkmcnt(0)" ::: "memory")
#define VM_WAIT() asm volatile("s_waitcnt vmcnt(0)" ::: "memory")
__device__ __forceinline__ unsigned f2bf(float f) { unsigned u = __builtin_bit_cast(unsigned, f); return (u + 0x7fffu + ((u >> 16) & 1u)) >> 16; }
__device__ __forceinline__ unsigned pk2(float lo, float hi) { return f2bf(lo) | (f2bf(hi) << 16); }
__device__ __forceinline__ float bf2f(unsigned h) { return __uint_as_float(h << 16); }

#define XB_TMO      128
#define XB_XCNT(j)  (256  + 64 * (j))
#define XB_XSUB(j)  (1280 + 64 * (j))
#define XB_XGEN(j)  (2304 + 64 * (j))
#define XB_TOP      3328
#define XB_TOPGEN   3392
#define XCD_BAR_WORDS 3456
#define XB_SPIN_CAP (1u << 18)

__device__ __forceinline__ unsigned xb_ld(unsigned* p)              { return __hip_atomic_load(p, __ATOMIC_RELAXED, __HIP_MEMORY_SCOPE_AGENT); }
__device__ __forceinline__ unsigned xb_add(unsigned* p, unsigned v) { return __hip_atomic_fetch_add(p, v, __ATOMIC_RELAXED, __HIP_MEMORY_SCOPE_AGENT); }
__device__ __forceinline__ unsigned xb_xcc_id() { return (unsigned)__builtin_amdgcn_s_getreg((3 << 11) | 20) & 0xFu; }
#define XB_SPIN(cond, bar) do { unsigned _sp = 0; while (cond) { __builtin_amdgcn_s_sleep(1); \
    if ((++_sp & 255u) == 0u) { if (xb_ld(&(bar)[XB_TMO])) break; if (_sp > XB_SPIN_CAP) { atomicAdd(&(bar)[XB_TMO], 1u); break; } } } } while (0)

struct XcdBarrier {
    unsigned* bar; unsigned x;
    volatile LAS unsigned* st;
};

__device__ __forceinline__ XcdBarrier xcd_barrier_post(unsigned* bar, volatile LAS unsigned* st) {
    XcdBarrier b; b.bar = bar; b.x = xb_xcc_id(); b.st = st;
    if (threadIdx.x == 0) (void)xb_add(&bar[XB_XCNT(b.x)], 1u);
    return b;
}
__device__ __forceinline__ void xcd_barrier_complete(unsigned* bar, unsigned x, unsigned& nloc, unsigned& nx) {
    const unsigned G = gridDim.x * gridDim.y * gridDim.z;
    unsigned sum, cnt, mine, sp = 0u;
    for (;;) {
        sum = 0u; cnt = 0u; mine = 0u;
#pragma unroll
        for (unsigned j = 0; j < 16; ++j) { const unsigned c = xb_ld(&bar[XB_XCNT(j)]); sum += c; cnt += (c > 0u) ? 1u : 0u; mine = (j == x) ? c : mine; }
        if (sum == G) break;
        __builtin_amdgcn_s_sleep(1);
        if ((++sp & 255u) == 0u) { if (xb_ld(&bar[XB_TMO])) break; if (sp > XB_SPIN_CAP) { atomicAdd(&bar[XB_TMO], 1u); break; } }
    }
    nloc = mine > 0u ? mine : 1u; nx = cnt > 0u ? cnt : 1u;
}

__device__ __forceinline__ void xcd_barrier(const XcdBarrier& b) {
    asm volatile("s_waitcnt vmcnt(0)" ::: "memory");
    __syncthreads();
    if (threadIdx.x == 0) {
        unsigned* bar = b.bar;
        __builtin_amdgcn_s_waitcnt(0);
        unsigned nloc = b.st[0], nx = b.st[1];
        if (nloc == 0u) { xcd_barrier_complete(bar, b.x, nloc, nx); b.st[0] = nloc; b.st[1] = nx; }
        const unsigned old = xb_add(&bar[XB_XSUB(b.x)], 1u);
        const unsigned gen = old / nloc;
        if (old + 1u == (gen + 1u) * nloc) {
            __builtin_amdgcn_fence(__ATOMIC_RELEASE, "agent");
            asm volatile("s_waitcnt vmcnt(0)" ::: "memory");
            const unsigned og = xb_add(&bar[XB_TOP], 1u);
            const unsigned tg = og / nx;
            if (og + 1u == (tg + 1u) * nx) xb_add(&bar[XB_TOPGEN], 1u);
            else XB_SPIN(xb_ld(&bar[XB_TOPGEN]) == tg, bar);
            __builtin_amdgcn_fence(__ATOMIC_ACQUIRE, "agent");
            xb_add(&bar[XB_XGEN(b.x)], 1u);
            asm volatile("s_waitcnt vmcnt(0)" ::: "memory");
        } else {
            XB_SPIN(xb_ld(&bar[XB_XGEN(b.x)]) == gen, bar);
            __builtin_amdgcn_fence(__ATOMIC_ACQUIRE, "agent");
            asm volatile("s_waitcnt vmcnt(0)" ::: "memory");
        }
    }
    __syncthreads();
}

struct Frame {
    LAS unsigned char* lds;
    volatile LAS unsigned* MISC;
    gu32* ctl;
    int tid, lane, wave;
    int vcu, G;
};
__device__ __forceinline__ float wave_sum(float v) {
#pragma unroll
    for (int o = 1; o < 64; o <<= 1) v += __shfl_xor(v, o);
    return v;
}
__device__ __forceinline__ float dot4(f32x4 a) { return (a.x * a.x + a.y * a.y) + (a.z * a.z + a.w * a.w); }

__device__ __forceinline__ void p0_transpose_item(const float* W, int N, bf16* WT, int ldk, size_t drow0, int k0, int n0, const float* kscale, LAS float* scr, int lane) {
#pragma unroll 8
    for (int i = 0; i < 32; ++i) { const int kk = 2 * i + (lane >> 5); scr[kk * 33 + (lane & 31)] = W[(size_t)(k0 + kk) * N + n0 + (lane & 31)]; }
    LDS_WAIT(); asm volatile("" ::: "memory");
    const int c = lane & 7;
    float sc[8];
#pragma unroll
    for (int j = 0; j < 8; ++j) sc[j] = kscale ? kscale[k0 + 8 * c + j] : 1.f;
#pragma unroll
    for (int j = 0; j < 4; ++j) { const int n = (lane >> 3) + 8 * j; const LAS float* s = scr + (8 * c) * 33 + n;
        v4u o; o.x = pk2(s[0 * 33] * sc[0], s[1 * 33] * sc[1]); o.y = pk2(s[2 * 33] * sc[2], s[3 * 33] * sc[3]); o.z = pk2(s[4 * 33] * sc[4], s[5 * 33] * sc[5]); o.w = pk2(s[6 * 33] * sc[6], s[7 * 33] * sc[7]);
        *(GAS v4u*)(WT + (drow0 + n) * (size_t)ldk + k0 + 8 * c) = o; }
    LDS_WAIT(); asm volatile("" ::: "memory");
}
__device__ __forceinline__ void rms_row_to_bf16(const float* xrow, const float* g, bf16* orow, int lane) {
    const GAS f32x4* xr = (const GAS f32x4*)xrow + lane;
    f32x4 v[8]; float s = 0.f;
#pragma unroll
    for (int j = 0; j < 8; ++j) { v[j] = xr[64 * j]; s += dot4(v[j]); }
    const float rstd = 1.f / sqrtf(wave_sum(s) * (1.f / D) + EPS);
    GAS unsigned long long* o8 = (GAS unsigned long long*)orow + lane;
#pragma unroll
    for (int j = 0; j < 8; ++j) { const f32x4 gv = ((const GAS f32x4*)g)[lane + 64 * j];
        o8[64 * j] = (unsigned long long)pk2(v[j].x * rstd * gv.x, v[j].y * rstd * gv.y) | ((unsigned long long)pk2(v[j].z * rstd * gv.z, v[j].w * rstd * gv.w) << 32); }
}
__device__ __forceinline__ double exp_d(double x) {
    const double kf = __builtin_rint(x * 1.4426950408889634074); const double r = x - kf * 0.6931471805599453094;
    double p = 1.0;
#pragma unroll
    for (int i = 18; i >= 1; --i) p = 1.0 + r * p * (1.0 / (double)i);
    return __builtin_ldexp(p, (int)kf);
}
__device__ __forceinline__ void sincos_d(double th, double& sn, double& cs) {
    const double k = __builtin_rint(th * 0.15915494309189533577); const double r = th - k * 6.283185307179586477; const double r2 = r * r;
    double s = 1.0, c = 1.0;
#pragma unroll
    for (int i = 15; i >= 1; --i) { s = 1.0 - r2 * s * (1.0 / (double)((2 * i) * (2 * i + 1))); c = 1.0 - r2 * c * (1.0 / (double)((2 * i - 1) * (2 * i))); }
    sn = r * s; cs = c;
}
__device__ __forceinline__ void p0_ssm_tables(Frame& F, int g, const float* lam_re, const float* lam_im, const float* log_dt, const float* b_re, const float* b_im,
                                              const float* c_re, const float* c_im, const float* d_skip, bf16* TE, bf16* WP, float* A16) {
    LAS float* Apr = (LAS float*)(F.lds);
    LAS float* Api = Apr + 17 * 64;
    LAS float* Bbr = Api + 17 * 64;
    LAS float* Bbi = Bbr + 1024;
    LAS float* Cr = Bbi + 1024;
    LAS float* Ci = Cr + 1024;
    LAS float* Dk = Ci + 1024;
    LAS float* Kt = Dk + 16;
    const int tid = F.tid;
    if (tid < 64) { const int p = tid;
        const double dt = exp_d((double)log_dt[g]); const double lr = (double)lam_re[g * 64 + p], li = (double)lam_im[g * 64 + p];
        const double mag = exp_d(lr * dt); double sn, cs; sincos_d(li * dt, sn, cs);
        const double ar = mag * cs, ai = mag * sn, den = lr * lr + li * li;
        const double cr = ((ar - 1.0) * lr + ai * li) / den, ci = (ai * lr - (ar - 1.0) * li) / den;
        double pr = 1.0, pi = 0.0;
        for (int t = 0; t < 17; ++t) { Apr[t * 64 + p] = (float)pr; Api[t * 64 + p] = (float)pi; const double nr = pr * ar - pi * ai, ni = pr * ai + pi * ar; pr = nr; pi = ni; }
        A16[(g * 64 + p) * 2 + 0] = Apr[16 * 64 + p]; A16[(g * 64 + p) * 2 + 1] = Api[16 * 64 + p];
        for (int hh = 0; hh < 16; ++hh) { const double br = (double)b_re[(g * 64 + p) * 16 + hh], bi = (double)b_im[(g * 64 + p) * 16 + hh];
            Bbr[p * 16 + hh] = (float)(cr * br - ci * bi); Bbi[p * 16 + hh] = (float)(cr * bi + ci * br); }
    }
    for (int i = tid; i < 1024; i += 512) { Cr[i] = c_re[g * 1024 + i]; Ci[i] = c_im[g * 1024 + i]; }
    if (tid < 16) Dk[tid] = d_skip[g * 16 + tid];
    __syncthreads();
    for (int i = 0; i < 8; ++i) { const int idx = tid + 512 * i, tau = idx >> 8, ho = (idx >> 4) & 15, hi = idx & 15; float acc = 0.f;
        for (int p = 0; p < 64; ++p) { const float a_r = Apr[tau * 64 + p], a_i = Api[tau * 64 + p], b_r = Bbr[p * 16 + hi], b_i = Bbi[p * 16 + hi];
            const float abr = a_r * b_r - a_i * b_i, abi = a_r * b_i + a_i * b_r; acc += Cr[ho * 64 + p] * abr - Ci[ho * 64 + p] * abi; }
        Kt[idx] = acc; }
    __syncthreads();
    for (int i = 0; i < 24; ++i) { const int v = tid + 512 * i, n = v / 48, kv = v - n * 48, tau = n >> 4, ho = n & 15; float val[8];
        if (kv < 32) { const int s = kv >> 1, hi0 = (kv & 1) * 8;
#pragma unroll
            for (int j = 0; j < 8; ++j) { float x = (s <= tau) ? Kt[(tau - s) * 256 + ho * 16 + hi0 + j] : 0.f; if (s == tau && hi0 + j == ho) x += Dk[ho]; val[j] = x; }
        } else {
#pragma unroll
            for (int j = 0; j < 8; ++j) { const int pe = (kv - 32) * 8 + j, p = pe & 63; const float a_r = Apr[(tau + 1) * 64 + p], a_i = Api[(tau + 1) * 64 + p], c_r = Cr[ho * 64 + p], c_i = Ci[ho * 64 + p];
                val[j] = (pe < 64) ? (c_r * a_r - c_i * a_i) : -(c_r * a_i + c_i * a_r); }
        }
        v4u o; o.x = pk2(val[0], val[1]); o.y = pk2(val[2], val[3]); o.z = pk2(val[4], val[5]); o.w = pk2(val[6], val[7]);
        *(GAS v4u*)(TE + ((size_t)(g * 256 + n)) * 384 + kv * 8) = o; }
    for (int i = 0; i < 16; ++i) { const int v = tid + 512 * i, n = v >> 5, kv = v & 31, s = kv >> 1, hi0 = (kv & 1) * 8; float val[8];
#pragma unroll
        for (int j = 0; j < 8; ++j) { float x = 0.f;
            if (n < 128) { const int p = n & 63; const float a_r = Apr[(15 - s) * 64 + p], a_i = Api[(15 - s) * 64 + p], b_r = Bbr[p * 16 + hi0 + j], b_i = Bbi[p * 16 + hi0 + j];
                x = (n < 64) ? (a_r * b_r - a_i * b_i) : (a_r * b_i + a_i * b_r); }
            val[j] = x; }
        v4u o; o.x = pk2(val[0], val[1]); o.y = pk2(val[2], val[3]); o.z = pk2(val[4], val[5]); o.w = pk2(val[6], val[7]);
        *(GAS v4u*)(WP + ((size_t)(g * 256 + n)) * 256 + kv * 8) = o; }
    __syncthreads();
}

__device__ const unsigned char T5_BUCKET[128] = {0, 1, 2, 3, 4, 5, 6, 7, 8, 9, 10, 11, 12, 13, 14, 15, 16, 16, 16, 17, 17, 18, 18, 18, 19, 19, 19, 20, 20, 20, 20, 21, 21, 21, 21, 22, 22, 22, 22, 22, 23, 23, 23, 23, 23, 23, 24, 24, 24, 24, 24, 24,
    25, 25, 25, 25, 25, 25, 25, 26, 26, 26, 26, 26, 26, 26, 26, 27, 27, 27, 27, 27, 27, 27, 27, 27, 27, 28, 28, 28, 28, 28, 28, 28, 28, 28, 28, 29, 29, 29, 29, 29, 29, 29, 29, 29, 29, 29, 29, 30, 30, 30, 30, 30, 30, 30, 30, 30, 30, 30, 30, 30, 30,
    31, 31, 31, 31, 31, 31, 31, 31, 31, 31, 31, 31, 31, 31, 31};
constexpr int AT_KS = 0, AT_KSTRIDE = 144, AT_VT = 256 * 144, AT_VSTRIDE = 528, AT_BT = AT_VT + 64 * 528;
constexpr float NEGBIG = -1e30f;
__device__ __forceinline__ void attn_unit(LAS unsigned char* lds, int b, int nb, int kvh, const bf16* Qb, const bf16* KV, const float* btab, const float* sinks, bf16* ATT, float* RSA, int tid, int lane, int wave) {
    const int head = kvh * 8 + wave;
    for (int i = tid; i < 8 * 192; i += 512) { const int w = i / 192, n = (i - w * 192) - 32; float v = NEGBIG; if (n >= 0 && n < 128) v = btab[(int)T5_BUCKET[n] * 16 + kvh * 8 + w] * LOG2E; ((LAS float*)(lds + AT_BT))[i] = v; }
    const long tok0 = (long)b * SEQ + (long)nb * 128 - 128;
#pragma unroll
    for (int i = 0; i < 4; ++i) { const int idx = tid + 512 * i, row = idx >> 3, ch = idx & 7;
        if (nb > 0 || row >= 128) {
            const bf16* src = KV + (tok0 + row) * 256 + kvh * 64 + ch * 8;
            const v4u kv = *(const GAS v4u*)src; const v4u vv = *(const GAS v4u*)(src + 128);
            *(LAS v4u*)(lds + AT_KS + row * AT_KSTRIDE + ch * 16) = kv;
            const int pos = (row & ~12) | ((row & 4) << 1) | ((row & 8) >> 1);
            LAS bf16* vt = (LAS bf16*)(lds + AT_VT) + (ch * 8) * 264 + pos;
            vt[0 * 264] = (bf16)(vv.x & 0xffffu); vt[1 * 264] = (bf16)(vv.x >> 16); vt[2 * 264] = (bf16)(vv.y & 0xffffu); vt[3 * 264] = (bf16)(vv.y >> 16);
            vt[4 * 264] = (bf16)(vv.z & 0xffffu); vt[5 * 264] = (bf16)(vv.z >> 16); vt[6 * 264] = (bf16)(vv.w & 0xffffu); vt[7 * 264] = (bf16)(vv.w >> 16);
        } }
    __syncthreads();
    const int r = lane & 31, h = lane >> 5;
    const float sinkL2 = sinks[head] * LOG2E;
    const LAS float* bt = (const LAS float*)(lds + AT_BT) + wave * 192 + 32 + (r - 4 * h);
    for (int j = 0; j < 4; ++j) {
        const long qrow = (long)b * SEQ + nb * 128 + 32 * j + r;
        bf16x8 qf[4];
#pragma unroll
        for (int ds = 0; ds < 4; ++ds) qf[ds] = *(const GAS bf16x8*)(Qb + qrow * 1024 + head * 64 + 16 * ds + 8 * h);
        f32x16 S[5];
#pragma unroll
        for (int c = 0; c < 5; ++c) { const int kt = j + c; const bool valid = (nb > 0) || (kt >= 4);
            f32x16 a;
#pragma unroll
            for (int reg = 0; reg < 16; ++reg) a[reg] = 0.f;
            if (valid) {
#pragma unroll
                for (int ds = 0; ds < 4; ++ds) { const bf16x8 kf = *(const LAS bf16x8*)(lds + AT_KS + (32 * kt + r) * AT_KSTRIDE + (16 * ds + 8 * h) * 2); a = __builtin_amdgcn_mfma_f32_32x32x16_bf16(kf, qf[ds], a, 0, 0, 0); }
#pragma unroll
                for (int reg = 0; reg < 16; ++reg) a[reg] += bt[128 - 32 * c - ((reg & 3) + 8 * (reg >> 2))];
            } else {
#pragma unroll
                for (int reg = 0; reg < 16; ++reg) a[reg] = NEGBIG;
            }
            S[c] = a; }
        float mx = sinkL2;
#pragma unroll
        for (int c = 0; c < 5; ++c)
#pragma unroll
            for (int reg = 0; reg < 16; ++reg) mx = fmaxf(mx, S[c][reg]);
        mx = fmaxf(mx, __shfl_xor(mx, 32));
        float l = 0.f;
#pragma unroll
        for (int c = 0; c < 5; ++c)
#pragma unroll
            for (int reg = 0; reg < 16; ++reg) { const float p = __builtin_amdgcn_exp2f(S[c][reg] - mx); S[c][reg] = p; l += p; }
        l += __shfl_xor(l, 32); l += __builtin_amdgcn_exp2f(sinkL2 - mx);
        f32x16 o0, o1;
#pragma unroll
        for (int reg = 0; reg < 16; ++reg) { o0[reg] = 0.f; o1[reg] = 0.f; }
#pragma unroll
        for (int c = 0; c < 5; ++c) { const int kt = j + c; const bool valid = (nb > 0) || (kt >= 4);
            if (valid) {
#pragma unroll
                for (int s2 = 0; s2 < 2; ++s2) { v4u pw; pw.x = pg8::cvt_pk_bf16(S[c][8 * s2 + 0], S[c][8 * s2 + 1]); pw.y = pg8::cvt_pk_bf16(S[c][8 * s2 + 2], S[c][8 * s2 + 3]);
                    pw.z = pg8::cvt_pk_bf16(S[c][8 * s2 + 4], S[c][8 * s2 + 5]); pw.w = pg8::cvt_pk_bf16(S[c][8 * s2 + 6], S[c][8 * s2 + 7]);
                    const bf16x8 pf = __builtin_bit_cast(bf16x8, pw);
                    const bf16x8 v0 = *(const LAS bf16x8*)(lds + AT_VT + r * AT_VSTRIDE + (32 * kt + 16 * s2 + 8 * h) * 2);
                    const bf16x8 v1 = *(const LAS bf16x8*)(lds + AT_VT + (32 + r) * AT_VSTRIDE + (32 * kt + 16 * s2 + 8 * h) * 2);
                    o0 = __builtin_amdgcn_mfma_f32_32x32x16_bf16(v0, pf, o0, 0, 0, 0); o1 = __builtin_amdgcn_mfma_f32_32x32x16_bf16(v1, pf, o1, 0, 0, 0); }
            } }
        const float inv = 1.0f / l; float ss = 0.f;
        bf16* orow = ATT + qrow * 1024 + head * 64 + 4 * h;
#pragma unroll
        for (int g4 = 0; g4 < 4; ++g4) { const float a0 = o0[4 * g4] * inv, a1 = o0[4 * g4 + 1] * inv, a2 = o0[4 * g4 + 2] * inv, a3 = o0[4 * g4 + 3] * inv;
            const float c0 = o1[4 * g4] * inv, c1 = o1[4 * g4 + 1] * inv, c2 = o1[4 * g4 + 2] * inv, c3 = o1[4 * g4 + 3] * inv;
            ss += (a0 * a0 + a1 * a1) + (a2 * a2 + a3 * a3) + (c0 * c0 + c1 * c1) + (c2 * c2 + c3 * c3);
            v2u w0; w0.x = pg8::cvt_pk_bf16(a0, a1); w0.y = pg8::cvt_pk_bf16(a2, a3); v2u w1; w1.x = pg8::cvt_pk_bf16(c0, c1); w1.y = pg8::cvt_pk_bf16(c2, c3);
            *(GAS v2u*)(orow + 8 * g4) = w0; *(GAS v2u*)(orow + 32 + 8 * g4) = w1; }
        ss += __shfl_xor(ss, 32);
        if (h == 0) RSA[qrow * 16 + head] = ss;
    }
    __syncthreads();
}

__device__ __forceinline__ void route_block(int R0, const float* xmid, bf16* TB, const bf16* WrH, const bf16* WrL, const float* brg, const float* bre, gu32* ctl, unsigned* rec, LAS float* lg, int lane) {
    const int r = lane & 15, kq = lane >> 4;
    f32x4 acc[3];
#pragma unroll
    for (int cb = 0; cb < 3; ++cb) acc[cb] = (f32x4){0.f, 0.f, 0.f, 0.f};
    float ss = 0.f;
    const float* xp = xmid + (size_t)(R0 + r) * D + kq * 8;
    bf16* tp = TB + (size_t)(R0 + r) * D + kq * 8;
    const bf16* wh = WrH + (size_t)r * D + kq * 8; const bf16* wl = WrL + (size_t)r * D + kq * 8;
#pragma unroll 2
    for (int ks = 0; ks < 64; ++ks) {
        const f32x4 a0 = *(const GAS f32x4*)(xp + ks * 32), a1 = *(const GAS f32x4*)(xp + ks * 32 + 4);
        ss += dot4(a0) + dot4(a1);
        v4u hw; hw.x = pk2(a0.x, a0.y); hw.y = pk2(a0.z, a0.w); hw.z = pk2(a1.x, a1.y); hw.w = pk2(a1.z, a1.w);
        *(GAS v4u*)(tp + ks * 32) = hw;
        v4u lw; lw.x = pk2(a0.x - bf2f(hw.x & 0xffffu), a0.y - __uint_as_float(hw.x & 0xffff0000u)); lw.y = pk2(a0.z - bf2f(hw.y & 0xffffu), a0.w - __uint_as_float(hw.y & 0xffff0000u));
        lw.z = pk2(a1.x - bf2f(hw.z & 0xffffu), a1.y - __uint_as_float(hw.z & 0xffff0000u)); lw.w = pk2(a1.z - bf2f(hw.w & 0xffffu), a1.w - __uint_as_float(hw.w & 0xffff0000u));
        const bf16x8 ah = __builtin_bit_cast(bf16x8, hw), al = __builtin_bit_cast(bf16x8, lw);
#pragma unroll
        for (int cb = 0; cb < 3; ++cb) { const bf16x8 bh = *(const GAS bf16x8*)(wh + (size_t)cb * 16 * D + ks * 32), bl = *(const GAS bf16x8*)(wl + (size_t)cb * 16 * D + ks * 32);
            acc[cb] = __builtin_amdgcn_mfma_f32_16x16x32_bf16(ah, bh, acc[cb], 0, 0, 0); acc[cb] = __builtin_amdgcn_mfma_f32_16x16x32_bf16(al, bh, acc[cb], 0, 0, 0); acc[cb] = __builtin_amdgcn_mfma_f32_16x16x32_bf16(ah, bl, acc[cb], 0, 0, 0); }
    }
    ss += __shfl_xor(ss, 16); ss += __shfl_xor(ss, 32);
#pragma unroll
    for (int cb = 0; cb < 3; ++cb)
#pragma unroll
        for (int reg = 0; reg < 4; ++reg) lg[(kq * 4 + reg) * 48 + cb * 16 + r] = acc[cb][reg];
    LDS_WAIT(); asm volatile("" ::: "memory");
    if (lane < 16) { const int row = lane; const float rstd = 1.f / sqrtf(ss * (1.f / D) + EPS); const LAS float* lr = lg + row * 48;
        float gl[4]; float gmax = -3.4e38f; int gi = 0;
#pragma unroll
        for (int j = 0; j < 4; ++j) { gl[j] = lr[j] * rstd + brg[j]; if (gl[j] > gmax) { gmax = gl[j]; gi = j; } }
        float gsum = 0.f;
#pragma unroll
        for (int j = 0; j < 4; ++j) gsum += __expf(gl[j] - gmax);
        const float gate = 1.f / gsum;
        float v0 = -3.4e38f, v1 = -3.4e38f; int i0 = 0, i1 = 0;
#pragma unroll
        for (int e = 0; e < 8; ++e) { const float v = lr[4 + gi * 8 + e] * rstd + bre[gi * 8 + e];
            if (v > v0) { v1 = v0; i1 = i0; v0 = v; i0 = e; } else if (v > v1) { v1 = v; i1 = e; } }
        const float w0 = gate / (1.f + __expf(v1 - v0)), w1 = gate - w0;
        const int E0 = gi * 8 + i0, E1 = gi * 8 + i1;
        const unsigned p0 = __hip_atomic_fetch_add(ctl + CW_CNT + 64 * E0, 1u, RLX_AGENT), p1 = __hip_atomic_fetch_add(ctl + CW_CNT + 64 * E1, 1u, RLX_AGENT);
        unsigned* rc = rec + (size_t)(R0 + row) * 8;
        v4u a; a.x = (unsigned)E0; a.y = p0; a.z = (unsigned)E1; a.w = p1; *(GAS v4u*)rc = a;
        v4u bq; bq.x = __float_as_uint(w0); bq.y = __float_as_uint(w1); bq.z = __float_as_uint(rstd); bq.w = 0u; *(GAS v4u*)(rc + 4) = bq;
    }
    LDS_WAIT(); asm volatile("" ::: "memory");
}

struct Args { const float* in[27]; float* out; unsigned char* ws; };
#ifndef PH_LAST
#define PH_LAST 12
#endif
#ifndef PHMASK
#define PHMASK 0xffff
#endif
typedef __attribute__((address_space(4))) const char* kargp_t;
__device__ __forceinline__ const void* karg(int k) { kargp_t p = (kargp_t)__builtin_amdgcn_kernarg_segment_ptr(); asm volatile("" : "+s"(p)); return *(const void* const __attribute__((address_space(4)))*)(p + 8 * k); }
#define KIN(k) ((const float*)karg(k))
#define KOUT() ((float*)karg(27))
#define KWS(T, off) ((T*)((unsigned char*)karg(28) + (off)))
__global__ void __launch_bounds__(NWAVES * 64, 2) hymba_fwd(Args args_unused) {
    extern __shared__ __attribute__((aligned(16))) unsigned char lds[];
    Frame F;
    F.lds = (LAS unsigned char*)lds;
    F.MISC = (volatile LAS unsigned*)(F.lds + MISC_OFF);
    F.tid = threadIdx.x; F.lane = F.tid & 63; F.wave = __builtin_amdgcn_readfirstlane(F.tid >> 6);
    F.G = gridDim.x; { const int bx = blockIdx.x; F.vcu = (F.G % 8 == 0) ? (bx % 8) * (F.G / 8) + bx / 8 : bx; }
    F.ctl = (gu32*)KWS(unsigned char, WS_CTL);
    for (int u = F.tid; u < (LDS_BYTES - LDSCTL_OFF) / 4; u += NWAVES * 64) ((LAS unsigned*)(F.lds + LDSCTL_OFF))[u] = 0u;
    __syncthreads();
    XcdBarrier bar = xcd_barrier_post((unsigned*)(F.ctl + CW_BAR), F.MISC + 8);
#define GRID_BAR() xcd_barrier(bar)
    const int gw = F.vcu * NWAVES + F.wave, NGW = F.G * NWAVES;
    LAS int* tbl = (LAS int*)(F.lds + TB_OFF);

    if (PHMASK & (1 << 0)) {
        if (F.vcu < 64) p0_ssm_tables(F, F.vcu, KIN(5), KIN(6), KIN(7), KIN(8), KIN(9), KIN(10), KIN(11), KIN(12), KWS(bf16, WS_TE), KWS(bf16, WS_WP), KWS(float, WS_SMALL + SM_A16));
        { const float* g_ffn = KIN(18); const float* wrg = KIN(19); const float* wre = KIN(21); bf16* WrH = KWS(bf16, WS_SMALL + SM_WRH); bf16* WrL = KWS(bf16, WS_SMALL + SM_WRL);
          const int gtid = F.vcu * 512 + F.tid, NGT = F.G * 512;
          for (int e = gtid; e < NRT * D; e += NGT) { const int j = e / D, k = e - j * D; float w = 0.f;
            if (j < 4) w = wrg[k * 4 + j]; else if (j < 36) w = wre[((size_t)((j - 4) >> 3) * D + k) * 8 + ((j - 4) & 7)];
            w *= g_ffn[k]; const unsigned hi = f2bf(w); WrH[e] = (bf16)hi; WrL[e] = (bf16)f2bf(w - bf2f(hi)); } }
        { LAS float* scr = (LAS float*)(F.lds + RING_OFF + F.wave * 16384);
          constexpr int IT_WIN = 32 * 72, IT_WGLU = 16 * 32, IT_WOUT = 32 * 64, IT_GU = 32 * 32 * 16, IT_DN = 32 * 8 * 64;
          constexpr int NITEMS = IT_WIN + IT_WGLU + IT_WOUT + 2 * IT_GU + IT_DN;
          const float* w_in = KIN(3); const float* w_glu = KIN(13); const float* w_out = KIN(17); const float* g_ffn = KIN(18); const float* w_gate = KIN(23); const float* w_up = KIN(24); const float* w_down = KIN(25);
          unsigned char* ws = KWS(unsigned char, 0);
          for (int it = gw; it < NITEMS; it += NGW) {
            int r = it;
            if (r < IT_WIN) { const int kb = r / 72, nb = r - kb * 72; p0_transpose_item(w_in, NPROJ, (bf16*)(ws + WS_WIN), D, (size_t)32 * nb, 64 * kb, 32 * nb, nullptr, scr, F.lane); continue; } r -= IT_WIN;
            if (r < IT_WGLU) { const int kb = r / 32, nb = r - kb * 32; p0_transpose_item(w_glu, DSSM, (bf16*)(ws + WS_WGLU), DSSM, (size_t)32 * nb, 64 * kb, 32 * nb, nullptr, scr, F.lane); continue; } r -= IT_WGLU;
            if (r < IT_WOUT) { const int kb = r / 64, nb = r - kb * 64; p0_transpose_item(w_out, D, (bf16*)(ws + WS_WOUT), D, (size_t)32 * nb, 64 * kb, 32 * nb, nullptr, scr, F.lane); continue; } r -= IT_WOUT;
            if (r < 2 * IT_GU) { const int up = r >= IT_GU ? 1 : 0; const int r2 = r - up * IT_GU, E = r2 >> 9, q = r2 & 511, kb = q >> 4, nb = q & 15, f0 = 32 * nb;
                const float* W = (up ? w_up : w_gate) + (size_t)E * D * DFF; const size_t drow0 = (size_t)E * 1024 + (f0 >> 7) * 256 + up * 128 + (f0 & 127);
                p0_transpose_item(W, DFF, (bf16*)(ws + WS_WGU), D, drow0, 64 * kb, f0, g_ffn, scr, F.lane); continue; } r -= 2 * IT_GU;
            { const int E = r >> 9, q = r & 511, kb = q >> 6, nb = q & 63; p0_transpose_item(w_down + (size_t)E * DFF * D, D, (bf16*)(ws + WS_WD), DFF, (size_t)E * D + 32 * nb, 64 * kb, 32 * nb, nullptr, scr, F.lane); }
          } }
        { const float* x = KIN(0); const float* g_mix = KIN(2); bf16* XN = KWS(bf16, WS_XN);
          for (int m = gw; m < M_TOK; m += NGW) rms_row_to_bf16(x + (size_t)m * D, g_mix, XN + (size_t)m * D, F.lane); }
        GRID_BAR();
    }
    if (PHMASK & (1 << 1)) {
        unsigned char* ws = KWS(unsigned char, 0);
        pg8::Gemm g{(const bf16*)(ws + WS_XN), (const bf16*)(ws + WS_WIN), D, D, D}; pg8::StaticOrder S; S.init(M_TOK, NPROJ, F.G, (int)blockIdx.x);
        pg8::EpiInProj E{(bf16*)(ws + WS_Q), (bf16*)(ws + WS_KV), (bf16*)(ws + WS_UX)};
        pg8::gemm_phase<pg8::EpiInProj, pg8::StaticOrder, true, true>(F.lds + RING_OFF, g, S, E);
        GRID_BAR();
    }
    if (PHMASK & (1 << 2)) {
        { unsigned char* ws = KWS(unsigned char, 0);
          pg8::Gemm g{(const bf16*)(ws + WS_UX), (const bf16*)(ws + WS_WP), 256, 384, 256}; pg8::DiagOrder S{F.G, (int)blockIdx.x}; pg8::EpiS E{(float*)(ws + WS_S)};
          pg8::gemm_phase<pg8::EpiS, pg8::DiagOrder, true, true>(F.lds + RING_OFF, g, S, E); }
        { unsigned char* ws = KWS(unsigned char, 0); const float* rel_bias = KIN(1); const float* sinks = KIN(4);
          for (int u = blockIdx.x; u < 256; u += F.G) attn_unit(F.lds + RING_OFF, u >> 6, (u >> 1) & 31, u & 1, (const bf16*)(ws + WS_Q), (const bf16*)(ws + WS_KV), rel_bias, sinks, (bf16*)(ws + WS_ATT), (float*)(ws + WS_RSA), F.tid, F.lane, F.wave); }
        GRID_BAR();
    }
    if (PHMASK & (1 << 3)) {
        if (F.wave == 0) { unsigned char* ws = KWS(unsigned char, 0); const float* A16 = (const float*)(ws + WS_SMALL + SM_A16); const float* Sst = (const float*)(ws + WS_S); bf16* UX = (bf16*)(ws + WS_UX);
          for (int pr = blockIdx.x; pr < 256; pr += F.G) { const int b = pr >> 6, g = pr & 63, p = F.lane;
            const float a_r = A16[(g * 64 + p) * 2], a_i = A16[(g * 64 + p) * 2 + 1]; float xr = 0.f, xi = 0.f;
            const float* Sp = Sst + ((size_t)(g * 1024 + b * 256)) * 128 + p; bf16* Xp = UX + ((size_t)(g * 1024 + b * 256)) * 384 + 256 + p;
            for (int c0 = 0; c0 < 256; c0 += 8) { float sr[8], si[8];
#pragma unroll
                for (int c = 0; c < 8; ++c) { sr[c] = Sp[(size_t)(c0 + c) * 128]; si[c] = Sp[(size_t)(c0 + c) * 128 + 64]; }
#pragma unroll
                for (int c = 0; c < 8; ++c) { Xp[(size_t)(c0 + c) * 384] = (bf16)f2bf(xr); Xp[(size_t)(c0 + c) * 384 + 64] = (bf16)f2bf(xi);
                    const float nr = a_r * xr - a_i * xi + sr[c], ni = a_r * xi + a_i * xr + si[c]; xr = nr; xi = ni; } } } }
        GRID_BAR();
    }
    if (PHMASK & (1 << 4)) {
        unsigned char* ws = KWS(unsigned char, 0);
        pg8::Gemm g{(const bf16*)(ws + WS_UX), (const bf16*)(ws + WS_TE), 384, 384, 384}; pg8::DiagOrder S{F.G, (int)blockIdx.x}; pg8::EpiY E{(bf16*)(ws + WS_YG)};
        pg8::gemm_phase<pg8::EpiY, pg8::DiagOrder, true, true>(F.lds + RING_OFF, g, S, E);
        GRID_BAR();
    }
    if (PHMASK & (1 << 5)) {
        unsigned char* ws = KWS(unsigned char, 0);
        pg8::Gemm g{(const bf16*)(ws + WS_YG), (const bf16*)(ws + WS_WGLU), DSSM, DSSM, DSSM}; pg8::StaticOrder S; S.init(M_TOK, DSSM, F.G, (int)blockIdx.x);
        pg8::EpiGLU E{(const bf16*)(ws + WS_YG), KIN(14), (bf16*)(ws + WS_SG), (float*)(ws + WS_RSS)};
        pg8::gemm_phase<pg8::EpiGLU, pg8::StaticOrder, true, true>(F.lds + RING_OFF, g, S, E);
        GRID_BAR();
    }
    if (PHMASK & (1 << 6)) {
        unsigned char* ws = KWS(unsigned char, 0); const float* g_att = KIN(15); const float* g_ssm = KIN(16);
        const float* RSA = (const float*)(ws + WS_RSA); const float* RSS = (const float*)(ws + WS_RSS); const bf16* ATT = (const bf16*)(ws + WS_ATT); const bf16* SG = (const bf16*)(ws + WS_SG); bf16* MIX = (bf16*)(ws + WS_MIX);
        for (int m = gw; m < M_TOK; m += NGW) {
            float sa = RSA[(size_t)m * 16 + (F.lane & 15)], ss = RSS[(size_t)m * 16 + (F.lane & 15)];
#pragma unroll
            for (int o = 1; o < 16; o <<= 1) { sa += __shfl_xor(sa, o); ss += __shfl_xor(ss, o); }
            const float ra = 1.f / sqrtf(sa * (1.f / DATT) + EPS), rs = 1.f / sqrtf(ss * (1.f / DSSM) + EPS);
#pragma unroll
            for (int j = 0; j < 2; ++j) { const int idx = (F.lane + 64 * j) * 8;
                { const v4u a = *(const GAS v4u*)(ATT + (size_t)m * 1024 + idx); const f32x4 g0 = *(const GAS f32x4*)(g_att + idx), g1 = *(const GAS f32x4*)(g_att + idx + 4); v4u o;
                  o.x = pk2(pg8::bf_lo(a.x) * ra * g0.x, pg8::bf_hi(a.x) * ra * g0.y); o.y = pk2(pg8::bf_lo(a.y) * ra * g0.z, pg8::bf_hi(a.y) * ra * g0.w);
                  o.z = pk2(pg8::bf_lo(a.z) * ra * g1.x, pg8::bf_hi(a.z) * ra * g1.y); o.w = pk2(pg8::bf_lo(a.w) * ra * g1.z, pg8::bf_hi(a.w) * ra * g1.w);
                  *(GAS v4u*)(MIX + (size_t)m * D + idx) = o; }
                { const v4u a = *(const GAS v4u*)(SG + (size_t)m * 1024 + idx); const f32x4 g0 = *(const GAS f32x4*)(g_ssm + idx), g1 = *(const GAS f32x4*)(g_ssm + idx + 4); v4u o;
                  o.x = pk2(pg8::bf_lo(a.x) * rs * g0.x, pg8::bf_hi(a.x) * rs * g0.y); o.y = pk2(pg8::bf_lo(a.y) * rs * g0.z, pg8::bf_hi(a.y) * rs * g0.w);
                  o.z = pk2(pg8::bf_lo(a.z) * rs * g1.x, pg8::bf_hi(a.z) * rs * g1.y); o.w = pk2(pg8::bf_lo(a.w) * rs * g1.z, pg8::bf_hi(a.w) * rs * g1.w);
                  *(GAS v4u*)(MIX + (size_t)m * D + 1024 + idx) = o; } } }
        GRID_BAR();
    }
    if (PHMASK & (1 << 7)) {
        unsigned char* ws = KWS(unsigned char, 0);
        pg8::Gemm g{(const bf16*)(ws + WS_MIX), (const bf16*)(ws + WS_WOUT), D, D, D}; pg8::StaticOrder S; S.init(M_TOK, D, F.G, (int)blockIdx.x); pg8::EpiOut E{KIN(0), KOUT()};
        pg8::gemm_phase<pg8::EpiOut, pg8::StaticOrder, true, true>(F.lds + RING_OFF, g, S, E);
        GRID_BAR();
    }
#if PH_LAST >= 8
    if (PHMASK & (1 << 8)) {
        unsigned char* ws = KWS(unsigned char, 0); const float* xm = KOUT(); const float* brg = KIN(20); const float* bre = KIN(22);
        LAS float* lg = (LAS float*)(F.lds + RING_OFF) + F.wave * (16 * 48);
        for (int blk = gw; blk < M_TOK / 16; blk += NGW) route_block(blk * 16, xm, (bf16*)(ws + WS_TB), (const bf16*)(ws + WS_SMALL + SM_WRH), (const bf16*)(ws + WS_SMALL + SM_WRL), brg, bre, F.ctl, (unsigned*)(ws + WS_ROUTE + RT_REC), lg, F.lane);
        GRID_BAR();
    }
    if (PHMASK & (1 << 9)) {
        if (F.tid == 0) { int acc = 0; for (int e = 0; e < 32; ++e) { tbl[e] = acc; acc += (int)((__hip_atomic_load(F.ctl + CW_CNT + 64 * e, RLX_AGENT) + 255u) >> 8); } tbl[32] = acc; }
        __syncthreads();
        unsigned char* ws = KWS(unsigned char, 0); const unsigned* REC = (const unsigned*)(ws + WS_ROUTE + RT_REC); const bf16* TB = (const bf16*)(ws + WS_TB); bf16* TG = (bf16*)(ws + WS_TG);
        float* SLOTW = (float*)(ws + WS_ROUTE + RT_SLOTW); float* SLOTR = (float*)(ws + WS_ROUTE + RT_SLOTR); unsigned* TOKSLOT = (unsigned*)(ws + WS_ROUTE + RT_TOKSLOT);
        for (int tok = gw; tok < M_TOK; tok += NGW) { const v4u a = *(const GAS v4u*)(REC + (size_t)tok * 8); const v4u bq = *(const GAS v4u*)(REC + (size_t)tok * 8 + 4);
            const unsigned s0 = (unsigned)tbl[a.x] * 256u + a.y, s1 = (unsigned)tbl[a.z] * 256u + a.w;
            const GAS v4u* src = (const GAS v4u*)(TB + (size_t)tok * D) + F.lane; GAS v4u* d0 = (GAS v4u*)(TG + (size_t)s0 * D) + F.lane; GAS v4u* d1 = (GAS v4u*)(TG + (size_t)s1 * D) + F.lane;
#pragma unroll
            for (int j = 0; j < 4; ++j) { const v4u v = src[64 * j]; d0[64 * j] = v; d1[64 * j] = v; }
            if (F.lane == 0) { SLOTW[s0] = __uint_as_float(bq.x); SLOTW[s1] = __uint_as_float(bq.y); SLOTR[s0] = __uint_as_float(bq.z); SLOTR[s1] = __uint_as_float(bq.z); TOKSLOT[tok * 2] = s0; TOKSLOT[tok * 2 + 1] = s1; } }
        GRID_BAR();
    }
    if (PHMASK & (1 << 10)) {
        unsigned char* ws = KWS(unsigned char, 0);
        pg8::Gemm g{(const bf16*)(ws + WS_TG), (const bf16*)(ws + WS_WGU), D, D, D}; pg8::MoeOrder S{tbl, 4, F.G, (int)blockIdx.x};
        pg8::EpiSwiGLU E{(const float*)(ws + WS_ROUTE + RT_SLOTR), (const float*)(ws + WS_ROUTE + RT_SLOTW), (bf16*)(ws + WS_HID)};
        pg8::gemm_phase<pg8::EpiSwiGLU, pg8::MoeOrder, true, true>(F.lds + RING_OFF, g, S, E);
        GRID_BAR();
    }
    if (PHMASK & (1 << 11)) {
        unsigned char* ws = KWS(unsigned char, 0);
        pg8::Gemm g{(const bf16*)(ws + WS_HID), (const bf16*)(ws + WS_WD), DFF, DFF, DFF}; pg8::MoeOrder S{tbl, 8, F.G, (int)blockIdx.x}; pg8::EpiDown E{(bf16*)(ws + WS_O)};
        pg8::gemm_phase<pg8::EpiDown, pg8::MoeOrder, true, true>(F.lds + RING_OFF, g, S, E);
        GRID_BAR();
    }
#endif
    if (PHMASK & (1 << 12)) {
        float* outp = KOUT(); const float* g_final = KIN(26);
#if PH_LAST >= 8
        unsigned char* ws = KWS(unsigned char, 0); const unsigned* TOKSLOT = (const unsigned*)(ws + WS_ROUTE + RT_TOKSLOT); const bf16* OB = (const bf16*)(ws + WS_O);
#endif
        for (int m = gw; m < M_TOK; m += NGW) {
            const GAS f32x4* xr = (const GAS f32x4*)(outp + (size_t)m * D) + F.lane; f32x4 v[8]; float s = 0.f;
#if PH_LAST >= 8
            const unsigned s0 = TOKSLOT[m * 2], s1 = TOKSLOT[m * 2 + 1];
            const GAS v2u* o0 = (const GAS v2u*)(OB + (size_t)s0 * D) + F.lane; const GAS v2u* o1 = (const GAS v2u*)(OB + (size_t)s1 * D) + F.lane;
#endif
#pragma unroll
            for (int j = 0; j < 8; ++j) { v[j] = xr[64 * j];
#if PH_LAST >= 8
                const v2u a = o0[64 * j], c = o1[64 * j];
                v[j].x += pg8::bf_lo(a.x) + pg8::bf_lo(c.x); v[j].y += pg8::bf_hi(a.x) + pg8::bf_hi(c.x); v[j].z += pg8::bf_lo(a.y) + pg8::bf_lo(c.y); v[j].w += pg8::bf_hi(a.y) + pg8::bf_hi(c.y);
#endif
                s += dot4(v[j]); }
            const float rstd = 1.f / sqrtf(wave_sum(s) * (1.f / D) + EPS);
            GAS f32x4* orow = (GAS f32x4*)(outp + (size_t)m * D) + F.lane;
#pragma unroll
            for (int j = 0; j < 8; ++j) { const f32x4 gv = ((const GAS f32x4*)g_final)[F.lane + 64 * j]; orow[64 * j] = v[j] * rstd * gv; }
        }
    }
}

extern "C" void kernel_launch(void* const* d_in, const int* in_sizes, int n_in, void* d_out, int out_size, void* d_ws, size_t ws_size, hipStream_t stream) {
    static int grid = 0;
    if (grid == 0) {
        if (n_in != 27 || in_sizes[0] != M_TOK * D || out_size != M_TOK * D || ws_size < WS_END) { fprintf(stderr, "kernel_launch: unexpected shapes (n_in %d, in0 %d, out %d, ws %zu < %zu)\n", n_in, n_in > 0 ? in_sizes[0] : -1, out_size, ws_size, (size_t)WS_END); grid = -1; return; }
        int dev = 0, cus = 0, per_cu = 0;
        if (hipGetDevice(&dev) != hipSuccess || hipDeviceGetAttribute(&cus, hipDeviceAttributeMultiprocessorCount, dev) != hipSuccess) { grid = -1; return; }
        if (hipFuncSetAttribute((const void*)hymba_fwd, hipFuncAttributeMaxDynamicSharedMemorySize, LDS_BYTES) != hipSuccess) { fprintf(stderr, "kernel_launch: hipFuncSetAttribute failed\n"); grid = -1; return; }
        if (hipOccupancyMaxActiveBlocksPerMultiprocessor(&per_cu, (const void*)hymba_fwd, NWAVES * 64, LDS_BYTES) != hipSuccess || per_cu < 1)
            fprintf(stderr, "kernel_launch: note: occupancy query reports %d workgroups per CU\n", per_cu);
        (void)hipGetLastError();
        grid = cus;
    }
    if (grid < 0) return;
    if (hipMemsetAsync((char*)d_ws + WS_CTL, 0, CTL_ZERO_BYTES, stream) != hipSuccess) return;
    Args a{};
    for (int i = 0; i < 27; ++i) a.in[i] = (const float*)d_in[i];
    a.out = (float*)d_out; a.ws = (unsigned char*)d_ws;
    hipLaunchKernelGGL(hymba_fwd, dim3(grid), dim3(NWAVES * 64), LDS_BYTES, stream, a);
}
```

```cpp
#include <hip/hip_runtime.h>
#include <cstdio>
#include <cstdint>
namespace pg8 {
#define PG8_LAS __attribute__((address_space(3)))
typedef unsigned short bf16_t;
typedef short bf16x8 __attribute__((ext_vector_type(8)));
typedef float f32x4 __attribute__((ext_vector_type(4)));
typedef float f32x2 __attribute__((ext_vector_type(2)));
typedef unsigned u32x4 __attribute__((ext_vector_type(4)));
typedef unsigned u32x2 __attribute__((ext_vector_type(2)));
constexpr int BM = 256, BK = 64, HALF = 128, HTB = HALF * BK * 2  , STAGE_BYTES = 8 * HTB, NXCD = 8, WGM = 8;

__host__ __device__ __forceinline__ int lds_byte(int r, int c) { const int st = (r >> 4) * 2 + (c >> 5), rr = r & 15, cc = c & 31, ob = rr * 64 + cc * 2; return st * 1024 + (ob ^ (((ob >> 9) & 1) << 5)); }
__host__ __device__ __forceinline__ void stage_rc(int b, int& R, int& C) { const int st = b / 1024, sb = b % 1024, swz = sb ^ (((sb >> 9) & 1) << 5); R = (st >> 1) * 16 + swz / 64; C = (st & 1) * 32 + (swz % 64) / 2; }
__host__ __device__ __forceinline__ int perm32(int rho) { const int n = rho >> 4, i = rho & 15; return 8 * (i >> 2) + 4 * n + (i & 3); }

struct Unit { int pm, pn; };

struct StaticOrder {
    int nM, nN, nwg, G, c;
    __host__ __device__ void init(int M, int N, int G_, int c_) { nM = M / BM; nN = N / BM; nwg = nM * nN; G = G_; c = c_; }
    __host__ __device__ bool next(int i, Unit& u) const {
        const long L = (long)i * G + c; if (L >= nwg) return false;
        int wgid = (int)L; { const int q = nwg / NXCD, r = nwg % NXCD, xcd = wgid % NXCD, off = wgid / NXCD; wgid = (xcd < r ? xcd * (q + 1) : r * (q + 1) + (xcd - r) * q) + off; }
        const int nig = WGM * nN, gid = wgid / nig, fm = gid * WGM, gsz = (nM - fm) < WGM ? (nM - fm) : WGM;
        u.pm = fm + ((wgid % nig) % gsz); u.pn = (wgid % nig) / gsz; return true;
    }
    __device__ __forceinline__ void a_ready(const Unit&) const {}
    __device__ __forceinline__ void done(const Unit&) const {}
};
struct OneUnit {
    int pm, pn;
    __device__ bool next(int i, Unit& u) const { if (i > 0) return false; u.pm = pm; u.pn = pn; return true; }
};
struct MoeOrder {
    const PG8_LAS int* tb; int ntn, G, c;
    __device__ bool next(int i, Unit& u) const {
        const int L = i * G + c, NT = tb[32]; if (L >= NT * ntn) return false;
        const int tt = L / ntn, nt = L - tt * ntn; int E = 0;
#pragma unroll
        for (int e = 1; e < 32; ++e) E += (tt >= tb[e]) ? 1 : 0;
        u.pm = tt; u.pn = __builtin_amdgcn_readfirstlane(E * ntn + nt); return true;
    }
};

__device__ __forceinline__ unsigned cvt_pk_bf16(float lo, float hi) { unsigned r; asm volatile("v_cvt_pk_bf16_f32 %0, %1, %2" : "=v"(r) : "v"(lo), "v"(hi)); return r; }
__device__ __forceinline__ u32x4 pack8(const f32x4 a, const f32x4 b) { u32x4 w; w.x = cvt_pk_bf16(a[0], a[1]); w.y = cvt_pk_bf16(a[2], a[3]); w.z = cvt_pk_bf16(b[0], b[1]); w.w = cvt_pk_bf16(b[2], b[3]); return w; }
__device__ __forceinline__ float bf_lo(unsigned w) { return __uint_as_float(w << 16); }
__device__ __forceinline__ float bf_hi(unsigned w) { return __uint_as_float(w & 0xffff0000u); }
__device__ __forceinline__ float sigmoidf_(float v) { return __builtin_amdgcn_rcpf(1.0f + __builtin_amdgcn_exp2f(-1.4426950408889634f * v)); }
__device__ __forceinline__ float gelu_tanh_(float v) { const float z = v + 0.044715f * v * v * v; return v * __builtin_amdgcn_rcpf(1.0f + __builtin_amdgcn_exp2f(-2.3022081982f * z)); }

constexpr float QSCALE = 0.125f * 1.4426950408889634f;

struct EpiInProj {
    static constexpr bool PERM = true, MIDK = false;
    bf16_t* Q; bf16_t* KV; bf16_t* UX;
    __device__ __forceinline__ void operator()(const f32x4 (&acc)[2][2][4][2], const Unit& u, int wr, int wc, int fr, int fq) const {
        const int row0 = u.pm * BM + wr * 64 + fr, cw = wc * 32 + 8 * fq;
#pragma unroll
        for (int ai = 0; ai < 2; ++ai)
#pragma unroll
            for (int m = 0; m < 4; ++m) { const int row = row0 + ai * HALF + m * 16;
#pragma unroll
                for (int bj = 0; bj < 2; ++bj) { f32x4 v0 = acc[ai][bj][m][0], v1 = acc[ai][bj][m][1]; const int ct = bj * HALF + cw;
                    if (u.pn < 4) { v0 = v0 * QSCALE; v1 = v1 * QSCALE; *(u32x4*)(Q + (size_t)row * 1024 + u.pn * 256 + ct) = pack8(v0, v1); }
                    else if (u.pn == 4) { *(u32x4*)(KV + (size_t)row * 256 + ct) = pack8(v0, v1); }
                    else { const int ch = (u.pn - 5) * 256 + ct, g = ch >> 4, hi0 = ch & 15;
                        *(u32x4*)(UX + ((size_t)(g * 1024 + (row >> 4)) * 384 + (row & 15) * 16 + hi0)) = pack8(v0, v1); } } }
    }
};
struct EpiS {
    static constexpr bool PERM = false, MIDK = false;
    float* S;
    __device__ __forceinline__ void operator()(const f32x4 (&acc)[2][2][4][2], const Unit& u, int wr, int wc, int fr, int fq) const {
        const int row0 = u.pm * BM + wr * 64 + fr, col0 = wc * 32 + 4 * fq;
#pragma unroll
        for (int ai = 0; ai < 2; ++ai)
#pragma unroll
            for (int m = 0; m < 4; ++m) { float* rowp = S + (size_t)(row0 + ai * HALF + m * 16) * 128 + col0;
#pragma unroll
                for (int n = 0; n < 2; ++n) *(f32x4*)(rowp + n * 16) = acc[ai][0][m][n]; }
    }
};
struct EpiY {
    static constexpr bool PERM = true, MIDK = false;
    bf16_t* YG;
    __device__ __forceinline__ void operator()(const f32x4 (&acc)[2][2][4][2], const Unit& u, int wr, int wc, int fr, int fq) const {
        const int g = u.pm >> 2, s0 = (u.pm & 3) * 256 + wr * 64 + fr, cw = wc * 32 + 8 * fq;
#pragma unroll
        for (int ai = 0; ai < 2; ++ai)
#pragma unroll
            for (int m = 0; m < 4; ++m) { const int stream = s0 + ai * HALF + m * 16;
#pragma unroll
                for (int bj = 0; bj < 2; ++bj) { const int n = bj * HALF + cw, tau = n >> 4, ho0 = n & 15; f32x4 v0 = acc[ai][bj][m][0], v1 = acc[ai][bj][m][1];
#pragma unroll
                    for (int e = 0; e < 4; ++e) { v0[e] = gelu_tanh_(v0[e]); v1[e] = gelu_tanh_(v1[e]); }
                    *(u32x4*)(YG + (size_t)(stream * 16 + tau) * 1024 + g * 16 + ho0) = pack8(v0, v1); } }
    }
};
struct EpiGLU {
    static constexpr bool PERM = true, MIDK = false;
    const bf16_t* YG; const float* bias; bf16_t* SG; float* RS;
    __device__ __forceinline__ void operator()(const f32x4 (&acc)[2][2][4][2], const Unit& u, int wr, int wc, int fr, int fq) const {
        const int row0 = u.pm * BM + wr * 64 + fr, col0 = u.pn * BM + wc * 32 + 8 * fq;
        f32x4 bv[2][2];
#pragma unroll
        for (int bj = 0; bj < 2; ++bj)
#pragma unroll
            for (int n = 0; n < 2; ++n) bv[bj][n] = *(const f32x4*)(bias + col0 + bj * HALF + 4 * n);
#pragma unroll
        for (int ai = 0; ai < 2; ++ai)
#pragma unroll
            for (int m = 0; m < 4; ++m) { const int row = row0 + ai * HALF + m * 16; float ss = 0.f;
#pragma unroll
                for (int bj = 0; bj < 2; ++bj) { const size_t off = (size_t)row * 1024 + col0 + bj * HALF; const u32x4 yw = *(const u32x4*)(YG + off);
                    const f32x4 a0 = acc[ai][bj][m][0] + bv[bj][0], a1 = acc[ai][bj][m][1] + bv[bj][1]; f32x4 o0, o1;
                    o0[0] = bf_lo(yw.x) * sigmoidf_(a0[0]); o0[1] = bf_hi(yw.x) * sigmoidf_(a0[1]); o0[2] = bf_lo(yw.y) * sigmoidf_(a0[2]); o0[3] = bf_hi(yw.y) * sigmoidf_(a0[3]);
                    o1[0] = bf_lo(yw.z) * sigmoidf_(a1[0]); o1[1] = bf_hi(yw.z) * sigmoidf_(a1[1]); o1[2] = bf_lo(yw.w) * sigmoidf_(a1[2]); o1[3] = bf_hi(yw.w) * sigmoidf_(a1[3]);
                    ss += (o0[0] * o0[0] + o0[1] * o0[1]) + (o0[2] * o0[2] + o0[3] * o0[3]) + (o1[0] * o1[0] + o1[1] * o1[1]) + (o1[2] * o1[2] + o1[3] * o1[3]);
                    *(u32x4*)(SG + off) = pack8(o0, o1); }
                ss += __shfl_xor(ss, 16); ss += __shfl_xor(ss, 32);
                if (fq == 0) RS[(size_t)row * 16 + u.pn * 4 + wc] = ss; }
    }
};
struct EpiXmid {
    static constexpr bool PERM = true, MIDK = false;
    const float* X; bf16_t* T;
    __device__ __forceinline__ void operator()(const f32x4 (&acc)[2][2][4][2], const Unit& u, int wr, int wc, int fr, int fq) const {
        const int row0 = u.pm * BM + wr * 64 + fr, col0 = u.pn * BM + wc * 32 + 8 * fq;
#pragma unroll
        for (int ai = 0; ai < 2; ++ai)
#pragma unroll
            for (int m = 0; m < 4; ++m) { const size_t off = (size_t)(row0 + ai * HALF + m * 16) * 2048 + col0;
#pragma unroll
                for (int bj = 0; bj < 2; ++bj) { const size_t o = off + bj * HALF; const f32x4 x0 = *(const f32x4*)(X + o), x1 = *(const f32x4*)(X + o + 4);
                    *(u32x4*)(T + o) = pack8(x0 + acc[ai][bj][m][0], x1 + acc[ai][bj][m][1]); } }
    }
};
struct EpiSwiGLU {
    static constexpr bool PERM = true, MIDK = false;
    const float* ers; const float* ew; bf16_t* HID; const PG8_LAS int* tb;
    __device__ __forceinline__ void operator()(const f32x4 (&acc)[2][2][4][2], const Unit& u, int wr, int wc, int fr, int fq) const {
        const int Ex = u.pn >> 2, lb = Ex * 16384 + (u.pm - tb[Ex]) * 256 + wr * 64 + fr;
        const int row0 = u.pm * BM + wr * 64 + fr, col0 = (u.pn & 3) * 128 + wc * 32 + 8 * fq;
#pragma unroll
        for (int ai = 0; ai < 2; ++ai)
#pragma unroll
            for (int m = 0; m < 4; ++m) { const int slot = row0 + ai * HALF + m * 16, li = lb + ai * HALF + m * 16; const float rs = ers[li], w = ew[li]; f32x4 o[2];
#pragma unroll
                for (int n = 0; n < 2; ++n)
#pragma unroll
                    for (int e = 0; e < 4; ++e) { const float gt = acc[ai][0][m][n][e] * rs, up = acc[ai][1][m][n][e] * rs; o[n][e] = gt * sigmoidf_(gt) * up * w; }
                *(u32x4*)(HID + (size_t)slot * 512 + col0) = pack8(o[0], o[1]); }
    }
};
struct EpiDown {
    static constexpr bool PERM = true, MIDK = false;
    bf16_t* O;
    __device__ __forceinline__ void operator()(const f32x4 (&acc)[2][2][4][2], const Unit& u, int wr, int wc, int fr, int fq) const {
        const int row0 = u.pm * BM + wr * 64 + fr, col0 = (u.pn & 7) * 256 + wc * 32 + 8 * fq;
#pragma unroll
        for (int ai = 0; ai < 2; ++ai)
#pragma unroll
            for (int m = 0; m < 4; ++m) { bf16_t* rowp = O + (size_t)(row0 + ai * HALF + m * 16) * 2048 + col0;
#pragma unroll
                for (int bj = 0; bj < 2; ++bj) *(u32x4*)(rowp + bj * HALF) = pack8(acc[ai][bj][m][0], acc[ai][bj][m][1]); }
    }
};

template <class Epi, class Sched, int K, int LDA, int LDB, bool GATHER = false>
__device__ __forceinline__ void gemm_phase(PG8_LAS unsigned char* lds, const bf16_t* Ab, const bf16_t* Bb, const Sched& S, const Epi& E, const PG8_LAS int* gidx = nullptr) {
    int tid_ = threadIdx.x; asm volatile("" : "+v"(tid_));
    const int tid = tid_, wid = __builtin_amdgcn_readfirstlane(tid >> 6), lane = tid & 63, wr = wid >> 2, wc = wid & 3, fr = lane & 15, fq = lane >> 4;
    constexpr int nt = K / BK;
    static_assert(K % 128 == 0 && K >= 256, "K multiple of 128, >= 256");
    unsigned voffA[2], voffB[2], voffG[2][2];
#pragma unroll
    for (int i = 0; i < 2; ++i) { int R, C; stage_rc(tid * 16 + i * 8192, R, C); const int Rb = Epi::PERM ? ((R & ~31) + perm32(R & 31)) : R;
        voffA[i] = (unsigned)(R * LDA + C) * 2u; voffB[i] = (unsigned)(Rb * LDB + C) * 2u; voffG[0][i] = 0u; voffG[1][i] = 0u; }
    constexpr size_t kstep = (size_t)(BK * 2);
    constexpr size_t hstepA = GATHER ? 0 : (size_t)HALF * LDA * 2, hstepB = (size_t)HALF * LDB * 2;
    constexpr size_t tstepA = 2 * hstepA, tstepB = 2 * hstepB;
    const unsigned ldsw = (unsigned)wid * 1024u;
    const int aoff = lds_byte(wr * 64 + fr, fq * 8), boff = lds_byte(wc * 32 + fr, fq * 8);
#define PG8_SA(b, h) (((b) * 2 + (h)) * HTB)
#define PG8_SB(b, h) ((4 + (b) * 2 + (h)) * HTB)
#define PG8_STAGE(bufoff, gbase, voff) do { _Pragma("unroll") for (int _i = 0; _i < 2; ++_i) \
        __builtin_amdgcn_global_load_lds((const unsigned*)((const char*)(gbase) + (voff)[_i]), (PG8_LAS unsigned*)(lds + (bufoff) + ldsw + _i * 8192), 16, 0, 0); } while (0)
#define PG8_STA(b, h, ptr) do { if constexpr (GATHER) PG8_STAGE(PG8_SA(b, h), ptr, voffG[h]); else PG8_STAGE(PG8_SA(b, h), (ptr) + (h) * hstepA, voffA); } while (0)
#define PG8_LOADG(uord) do { _Pragma("unroll") for (int _h = 0; _h < 2; ++_h) _Pragma("unroll") for (int _i = 0; _i < 2; ++_i) { int R_, C_; stage_rc(tid * 16 + _i * 8192, R_, C_); \
        const int tok_ = gidx[(uord) * 256 + _h * 128 + R_]; voffG[_h][_i] = (unsigned)(tok_ * LDA + C_) * 2u; } } while (0)
#define PG8_LDA(dst, b, h) do { _Pragma("unroll") for (int m = 0; m < 4; ++m) _Pragma("unroll") for (int k = 0; k < 2; ++k) dst[m][k] = *(const PG8_LAS bf16x8*)(lds + PG8_SA(b, h) + aoff + m * 2048 + k * 1024); } while (0)
#define PG8_LDB(dst, b, h) do { _Pragma("unroll") for (int n = 0; n < 2; ++n) _Pragma("unroll") for (int k = 0; k < 2; ++k) dst[n][k] = *(const PG8_LAS bf16x8*)(lds + PG8_SB(b, h) + boff + n * 2048 + k * 1024); } while (0)
#define PG8_MMA(ai, bj, At, Bt) do { __builtin_amdgcn_s_setprio(1); _Pragma("unroll") for (int m = 0; m < 4; ++m) _Pragma("unroll") for (int n = 0; n < 2; ++n) _Pragma("unroll") for (int k = 0; k < 2; ++k) \
        acc[ai][bj][m][n] = __builtin_amdgcn_mfma_f32_16x16x32_bf16(Bt[n][k], At[m][k], acc[ai][bj][m][n], 0, 0, 0); __builtin_amdgcn_s_setprio(0); } while (0)
#define PG8_WAIT_V(n) asm volatile("s_waitcnt vmcnt(" #n ")" ::: "memory")
#define PG8_WAIT_L(n) asm volatile("s_waitcnt lgkmcnt(" #n ")" ::: "memory")
#define PG8_BAR __builtin_amdgcn_s_barrier()
#define PG8_SCHED __builtin_amdgcn_sched_barrier(0)
    Unit cur, nxt; int ui = 0;
    if (!S.next(0, cur)) return;
    f32x4 acc[2][2][4][2];
#pragma unroll
    for (int a = 0; a < 2; ++a)
#pragma unroll
        for (int b = 0; b < 2; ++b)
#pragma unroll
            for (int m = 0; m < 4; ++m)
#pragma unroll
                for (int n = 0; n < 2; ++n) acc[a][b][m][n] = (f32x4){0.f, 0.f, 0.f, 0.f};
    bf16x8 At[4][2], B0[2][2], B1[2][2];
    const char* cA = (const char*)Ab + (size_t)cur.pm * tstepA; const char* cB = (const char*)Bb + (size_t)cur.pn * tstepB;
    if constexpr (GATHER) { PG8_LOADG(0); }
    PG8_STAGE(PG8_SB(0, 0), cB, voffB); PG8_STAGE(PG8_SB(0, 1), cB + hstepB, voffB); PG8_STA(0, 0, cA); PG8_STA(0, 1, cA);
    if (wr == 1) PG8_BAR;
    PG8_WAIT_V(2); PG8_BAR;
    PG8_STAGE(PG8_SB(1, 0), cB + kstep, voffB); PG8_STA(1, 0, cA + kstep); PG8_STAGE(PG8_SB(1, 1), cB + hstepB + kstep, voffB);
    PG8_WAIT_V(6); PG8_BAR;
    for (;;) {
        const bool has_next = S.next(ui + 1, nxt);
        const char* nA = has_next ? (const char*)Ab + (size_t)nxt.pm * tstepA : cA; const char* nB = has_next ? (const char*)Bb + (size_t)nxt.pn * tstepB : cB;
        for (int t = 0; t < nt; t += 2) {
            const bool last = (t == nt - 2);
            const char* a1 = cA + (size_t)(t + 1) * kstep;
            const char* a2 = last ? nA : cA + (size_t)(t + 2) * kstep; const char* b2 = last ? nB : cB + (size_t)(t + 2) * kstep;
            const char* a3 = a2 + kstep; const char* b3 = b2 + kstep;
            if constexpr (Epi::MIDK) { if (t == nt / 2) E.midk(acc, cur, wr, fr); }
            PG8_LDB(B0, 0, 0); PG8_LDB(B1, 0, 1); PG8_SCHED; PG8_LDA(At, 0, 0); PG8_STA(1, 1, a1);
            if constexpr (GATHER) { if (last && has_next) { PG8_LOADG(ui + 1); } }
            PG8_WAIT_V(8); PG8_WAIT_L(0); PG8_BAR; PG8_MMA(0, 0, At, B0); PG8_MMA(0, 1, At, B1); PG8_BAR; PG8_SCHED;
            PG8_LDA(At, 0, 1); PG8_STAGE(PG8_SB(0, 0), b2, voffB); PG8_STAGE(PG8_SB(0, 1), b2 + hstepB, voffB); PG8_STA(0, 0, a2);
            PG8_WAIT_V(8); PG8_WAIT_L(0); PG8_BAR; PG8_MMA(1, 0, At, B0); PG8_MMA(1, 1, At, B1); PG8_BAR; PG8_SCHED;
            PG8_LDB(B0, 1, 0); PG8_LDB(B1, 1, 1); PG8_SCHED; PG8_LDA(At, 1, 0); PG8_STA(0, 1, a2);
            PG8_WAIT_V(8); PG8_WAIT_L(0); PG8_BAR; PG8_MMA(0, 0, At, B0); PG8_MMA(0, 1, At, B1); PG8_BAR; PG8_SCHED;
            PG8_LDA(At, 1, 1); PG8_STAGE(PG8_SB(1, 0), b3, voffB); PG8_STAGE(PG8_SB(1, 1), b3 + hstepB, voffB); PG8_STA(1, 0, a3);
            PG8_WAIT_V(8); PG8_WAIT_L(0); PG8_BAR; PG8_MMA(1, 0, At, B0); PG8_MMA(1, 1, At, B1); PG8_BAR; PG8_SCHED;
        }
        if (wr == 0) PG8_BAR;
        E(acc, cur, wr, wc, fr, fq);
        if (!has_next) break;
#pragma unroll
        for (int a = 0; a < 2; ++a)
#pragma unroll
            for (int b = 0; b < 2; ++b)
#pragma unroll
                for (int m = 0; m < 4; ++m)
#pragma unroll
                    for (int n = 0; n < 2; ++n) acc[a][b][m][n] = (f32x4){0.f, 0.f, 0.f, 0.f};
        cur = nxt; cA = nA; cB = nB; ++ui;
        if (wr == 1) PG8_BAR;
    }
    PG8_WAIT_V(0);
    PG8_BAR;
#undef PG8_SA
#undef PG8_SB
#undef PG8_STAGE
#undef PG8_STA
#undef PG8_LOADG
#undef PG8_LDA
#undef PG8_LDB
#undef PG8_MMA
#undef PG8_WAIT_V
#undef PG8_WAIT_L
#undef PG8_BAR
#undef PG8_SCHED
}
}

constexpr int NWAVES = 8;
constexpr int M_TOK = 16384, D = 2048, SEQ = 4096, NB_ = 4;
constexpr int NPROJ = 2304, DATT = 1024, DSSM = 1024;
constexpr int NEXP = 32, DFF = 512, NRT = 48;
constexpr int MAXTILES = 160, MAXSLOTS = MAXTILES * 256;
constexpr float EPS = 1e-6f;
constexpr float LOG2E = 1.4426950408889634f;

constexpr size_t MiB = 1u << 20;
constexpr size_t WS_CTL = 0, CTL_ZERO_BYTES = 1 * MiB;
constexpr size_t WS_SMALL = 1 * MiB;
constexpr size_t SM_A16 = 0, SM_WRH = 64 * 1024, SM_WRL = SM_WRH + (size_t)NRT * D * 2;
constexpr size_t WS_WIN = 2 * MiB, WS_WGLU = 11 * MiB, WS_WOUT = 13 * MiB, WS_TE = 21 * MiB, WS_WP = 33 * MiB, WS_WGU = 41 * MiB, WS_WD = 169 * MiB;
constexpr size_t WS_XN = 233 * MiB, WS_Q = 297 * MiB, WS_KV = 329 * MiB, WS_UX = 337 * MiB;
constexpr size_t WS_S = 233 * MiB, WS_ATT = 265 * MiB;
constexpr size_t WS_RSA = 385 * MiB, WS_RSS = 386 * MiB;
constexpr size_t WS_YG = 387 * MiB, WS_SG = 419 * MiB, WS_MIX = 451 * MiB;
constexpr size_t WS_TB = 233 * MiB, WS_HID = 457 * MiB, WS_O = 297 * MiB, WS_ROUTE = 497 * MiB;
constexpr size_t RT_REC = 0, RT_ETOK = 1 * MiB, RT_EW = 3 * MiB, RT_ERS = 5 * MiB;
constexpr size_t WS_END = 515 * MiB;
static_assert(WS_O + (size_t)MAXSLOTS * D * 2 <= WS_HID && WS_HID + (size_t)MAXSLOTS * DFF * 2 <= WS_ROUTE && WS_ROUTE + 7 * MiB <= WS_END, "d_ws map");
constexpr int CW_TMO = 0, CW_CODE = 1;
constexpr int CW_BAR = 4096;
constexpr int CW_CNT = 16384;

constexpr int RING_OFF = 0, RING_BYTES = 131072;
constexpr int LDSCTL_OFF = RING_BYTES, MISC_OFF = LDSCTL_OFF + 320, TB_OFF = LDSCTL_OFF + 1024;
constexpr int GIDX_OFF = LDSCTL_OFF + 2048;
constexpr int LDS_BYTES = 147456;

#define GAS __attribute__((address_space(1)))
#define LAS __attribute__((address_space(3)))
typedef unsigned short bf16;
typedef unsigned v4u __attribute__((ext_vector_type(4)));
typedef unsigned v2u __attribute__((ext_vector_type(2)));
typedef float f32x4 __attribute__((ext_vector_type(4)));
typedef float f32x16 __attribute__((ext_vector_type(16)));
typedef short bf16x8 __attribute__((ext_vector_type(8)));
typedef GAS unsigned gu32;
#define RLX_AGENT __ATOMIC_RELAXED, __HIP_MEMORY_SCOPE_AGENT
#define LDS_WAIT() asm volatile("s_waitcnt lgkmcnt(0)" ::: "memory")
#define VM_WAIT() asm volatile("s_waitcnt vmcnt(0)" ::: "memory")
__device__ __forceinline__ unsigned f2bf(float f) { unsigned u = __builtin_bit_cast(unsigned, f); return (u + 0x7fffu + ((u >> 16) & 1u)) >> 16; }
__device__ __forceinline__ unsigned pk2(float lo, float hi) { return f2bf(lo) | (f2bf(hi) << 16); }
__device__ __forceinline__ float bf2f(unsigned h) { return __uint_as_float(h << 16); }

#define XB_TMO      128
#define XB_XCNT(j)  (256  + 64 * (j))
#define XB_XSUB(j)  (1280 + 64 * (j))
#define XB_XGEN(j)  (2304 + 64 * (j))
#define XB_TOP      3328
#define XB_TOPGEN   3392
#define XCD_BAR_WORDS 3456
#define XB_SPIN_CAP (1u << 18)

__device__ __forceinline__ unsigned xb_ld(unsigned* p)              { return __hip_atomic_load(p, __ATOMIC_RELAXED, __HIP_MEMORY_SCOPE_AGENT); }
__device__ __forceinline__ unsigned xb_add(unsigned* p, unsigned v) { return __hip_atomic_fetch_add(p, v, __ATOMIC_RELAXED, __HIP_MEMORY_SCOPE_AGENT); }
__device__ __forceinline__ unsigned xb_xcc_id() { return (unsigned)__builtin_amdgcn_s_getreg((3 << 11) | 20) & 0xFu; }
#define XB_SPIN(cond, bar) do { unsigned _sp = 0; while (cond) { __builtin_amdgcn_s_sleep(1); \
    if ((++_sp & 255u) == 0u) { if (xb_ld(&(bar)[XB_TMO])) break; if (_sp > XB_SPIN_CAP) { atomicAdd(&(bar)[XB_TMO], 1u); break; } } } } while (0)

struct XcdBarrier {
    unsigned* bar; unsigned x;
    volatile LAS unsigned* st;
};

__device__ __forceinline__ XcdBarrier xcd_barrier_post(unsigned* bar, volatile LAS unsigned* st) {
    XcdBarrier b; b.bar = bar; b.x = xb_xcc_id(); b.st = st;
    if (threadIdx.x == 0) (void)xb_add(&bar[XB_XCNT(b.x)], 1u);
    return b;
}
__device__ __forceinline__ void xcd_barrier_complete(unsigned* bar, unsigned x, unsigned& nloc, unsigned& nx) {
    const unsigned G = gridDim.x * gridDim.y * gridDim.z;
    unsigned sum, cnt, mine, sp = 0u;
    for (;;) {
        sum = 0u; cnt = 0u; mine = 0u;
#pragma unroll
        for (unsigned j = 0; j < 16; ++j) { const unsigned c = xb_ld(&bar[XB_XCNT(j)]); sum += c; cnt += (c > 0u) ? 1u : 0u; mine = (j == x) ? c : mine; }
        if (sum == G) break;
        __builtin_amdgcn_s_sleep(1);
        if ((++sp & 255u) == 0u) { if (xb_ld(&bar[XB_TMO])) break; if (sp > XB_SPIN_CAP) { atomicAdd(&bar[XB_TMO], 1u); break; } }
    }
    nloc = mine > 0u ? mine : 1u; nx = cnt > 0u ? cnt : 1u;
}

__device__ __forceinline__ void xcd_barrier(const XcdBarrier& b) {
    asm volatile("s_waitcnt vmcnt(0)" ::: "memory");
    __syncthreads();
    if (threadIdx.x == 0) {
        unsigned* bar = b.bar;
        __builtin_amdgcn_s_waitcnt(0);
        unsigned nloc = b.st[0], nx = b.st[1];
        if (nloc == 0u) { xcd_barrier_complete(bar, b.x, nloc, nx); b.st[0] = nloc; b.st[1] = nx; }
        const unsigned old = xb_add(&bar[XB_XSUB(b.x)], 1u);
        const unsigned gen = old / nloc;
        if (old + 1u == (gen + 1u) * nloc) {
            __builtin_amdgcn_fence(__ATOMIC_RELEASE, "agent");
            asm volatile("s_waitcnt vmcnt(0)" ::: "memory");
            const unsigned og = xb_add(&bar[XB_TOP], 1u);
            const unsigned tg = og / nx;
            if (og + 1u == (tg + 1u) * nx) xb_add(&bar[XB_TOPGEN], 1u);
            else XB_SPIN(xb_ld(&bar[XB_TOPGEN]) == tg, bar);
            __builtin_amdgcn_fence(__ATOMIC_ACQUIRE, "agent");
            xb_add(&bar[XB_XGEN(b.x)], 1u);
            asm volatile("s_waitcnt vmcnt(0)" ::: "memory");
        } else {
            XB_SPIN(xb_ld(&bar[XB_XGEN(b.x)]) == gen, bar);
            __builtin_amdgcn_fence(__ATOMIC_ACQUIRE, "agent");
            asm volatile("s_waitcnt vmcnt(0)" ::: "memory");
        }
    }
    __syncthreads();
}

struct Frame {
    LAS unsigned char* lds;
    volatile LAS unsigned* MISC;
    gu32* ctl;
    int wave;
    int vcu, G;
};
__device__ __forceinline__ float wave_sum(float v) {
#pragma unroll
    for (int o = 1; o < 64; o <<= 1) v += __shfl_xor(v, o);
    return v;
}
__device__ __forceinline__ float dot4(f32x4 a) { return (a.x * a.x + a.y * a.y) + (a.z * a.z + a.w * a.w); }

__device__ __forceinline__ void p0_transpose_item(const float* W, int N, bf16* WT, int ldk, size_t drow0, int k0, int n0, const float* kscale, LAS float* scr, int lane) {
#pragma unroll 8
    for (int i = 0; i < 32; ++i) { const int kk = 2 * i + (lane >> 5); scr[kk * 33 + (lane & 31)] = W[(size_t)(k0 + kk) * N + n0 + (lane & 31)]; }
    LDS_WAIT(); asm volatile("" ::: "memory");
    const int c = lane & 7;
    float sc[8];
#pragma unroll
    for (int j = 0; j < 8; ++j) sc[j] = kscale ? kscale[k0 + 8 * c + j] : 1.f;
#pragma unroll
    for (int j = 0; j < 4; ++j) { const int n = (lane >> 3) + 8 * j; const LAS float* s = scr + (8 * c) * 33 + n;
        v4u o; o.x = pk2(s[0 * 33] * sc[0], s[1 * 33] * sc[1]); o.y = pk2(s[2 * 33] * sc[2], s[3 * 33] * sc[3]); o.z = pk2(s[4 * 33] * sc[4], s[5 * 33] * sc[5]); o.w = pk2(s[6 * 33] * sc[6], s[7 * 33] * sc[7]);
        *(GAS v4u*)(WT + (drow0 + n) * (size_t)ldk + k0 + 8 * c) = o; }
    LDS_WAIT(); asm volatile("" ::: "memory");
}
__device__ __forceinline__ void rms_row_to_bf16(const float* xrow, const float* g, bf16* orow, int lane) {
    const GAS f32x4* xr = (const GAS f32x4*)xrow + lane;
    f32x4 v[8]; float s = 0.f;
#pragma unroll
    for (int j = 0; j < 8; ++j) { v[j] = xr[64 * j]; s += dot4(v[j]); }
    const float rstd = 1.f / sqrtf(wave_sum(s) * (1.f / D) + EPS);
    GAS unsigned long long* o8 = (GAS unsigned long long*)orow + lane;
#pragma unroll
    for (int j = 0; j < 8; ++j) { const f32x4 gv = ((const GAS f32x4*)g)[lane + 64 * j];
        o8[64 * j] = (unsigned long long)pk2(v[j].x * rstd * gv.x, v[j].y * rstd * gv.y) | ((unsigned long long)pk2(v[j].z * rstd * gv.z, v[j].w * rstd * gv.w) << 32); }
}
__device__ __forceinline__ double exp_d(double x) {
    const double kf = __builtin_rint(x * 1.4426950408889634074); const double r = x - kf * 0.6931471805599453094;
    double p = 1.0;
#pragma unroll
    for (int i = 18; i >= 1; --i) p = 1.0 + r * p * (1.0 / (double)i);
    return __builtin_ldexp(p, (int)kf);
}
__device__ __forceinline__ void sincos_d(double th, double& sn, double& cs) {
    const double k = __builtin_rint(th * 0.15915494309189533577); const double r = th - k * 6.283185307179586477; const double r2 = r * r;
    double s = 1.0, c = 1.0;
#pragma unroll
    for (int i = 15; i >= 1; --i) { s = 1.0 - r2 * s * (1.0 / (double)((2 * i) * (2 * i + 1))); c = 1.0 - r2 * c * (1.0 / (double)((2 * i - 1) * (2 * i))); }
    sn = r * s; cs = c;
}
__device__ __forceinline__ void p0_ssm_tables(Frame& F, int g, const float* lam_re, const float* lam_im, const float* log_dt, const float* b_re, const float* b_im,
                                              const float* c_re, const float* c_im, const float* d_skip, bf16* TE, bf16* WP, float* A16) {
    LAS float* Apr = (LAS float*)(F.lds);
    LAS float* Api = Apr + 17 * 64;
    LAS float* Bbr = Api + 17 * 64;
    LAS float* Bbi = Bbr + 1024;
    LAS float* Cr = Bbi + 1024;
    LAS float* Ci = Cr + 1024;
    LAS float* Dk = Ci + 1024;
    LAS float* Kt = Dk + 16;
    int tid = threadIdx.x; asm volatile("" : "+v"(tid));
    if (tid < 64) { const int p = tid;
        const double dt = exp_d((double)log_dt[g]); const double lr = (double)lam_re[g * 64 + p], li = (double)lam_im[g * 64 + p];
        const double mag = exp_d(lr * dt); double sn, cs; sincos_d(li * dt, sn, cs);
        const double ar = mag * cs, ai = mag * sn, den = lr * lr + li * li;
        const double cr = ((ar - 1.0) * lr + ai * li) / den, ci = (ai * lr - (ar - 1.0) * li) / den;
        double pr = 1.0, pi = 0.0;
        for (int t = 0; t < 17; ++t) { Apr[t * 64 + p] = (float)pr; Api[t * 64 + p] = (float)pi; const double nr = pr * ar - pi * ai, ni = pr * ai + pi * ar; pr = nr; pi = ni; }
        A16[(g * 64 + p) * 2 + 0] = Apr[16 * 64 + p]; A16[(g * 64 + p) * 2 + 1] = Api[16 * 64 + p];
        for (int hh = 0; hh < 16; ++hh) { const double br = (double)b_re[(g * 64 + p) * 16 + hh], bi = (double)b_im[(g * 64 + p) * 16 + hh];
            Bbr[p * 16 + hh] = (float)(cr * br - ci * bi); Bbi[p * 16 + hh] = (float)(cr * bi + ci * br); }
    }
    for (int i = tid; i < 1024; i += 512) { Cr[i] = c_re[g * 1024 + i]; Ci[i] = c_im[g * 1024 + i]; }
    if (tid < 16) Dk[tid] = d_skip[g * 16 + tid];
    __syncthreads();
    for (int i = 0; i < 8; ++i) { const int idx = tid + 512 * i, tau = idx >> 8, ho = (idx >> 4) & 15, hi = idx & 15; float acc = 0.f;
        for (int p = 0; p < 64; ++p) { const float a_r = Apr[tau * 64 + p], a_i = Api[tau * 64 + p], b_r = Bbr[p * 16 + hi], b_i = Bbi[p * 16 + hi];
            const float abr = a_r * b_r - a_i * b_i, abi = a_r * b_i + a_i * b_r; acc += Cr[ho * 64 + p] * abr - Ci[ho * 64 + p] * abi; }
        Kt[idx] = acc; }
    __syncthreads();
    for (int i = 0; i < 24; ++i) { const int v = tid + 512 * i, n = v / 48, kv = v - n * 48, tau = n >> 4, ho = n & 15; float val[8];
        if (kv < 32) { const int s = kv >> 1, hi0 = (kv & 1) * 8;
#pragma unroll
            for (int j = 0; j < 8; ++j) { float x = (s <= tau) ? Kt[(tau - s) * 256 + ho * 16 + hi0 + j] : 0.f; if (s == tau && hi0 + j == ho) x += Dk[ho]; val[j] = x; }
        } else {
#pragma unroll
            for (int j = 0; j < 8; ++j) { const int pe = (kv - 32) * 8 + j, p = pe & 63; const float a_r = Apr[(tau + 1) * 64 + p], a_i = Api[(tau + 1) * 64 + p], c_r = Cr[ho * 64 + p], c_i = Ci[ho * 64 + p];
                val[j] = (pe < 64) ? (c_r * a_r - c_i * a_i) : -(c_r * a_i + c_i * a_r); }
        }
        v4u o; o.x = pk2(val[0], val[1]); o.y = pk2(val[2], val[3]); o.z = pk2(val[4], val[5]); o.w = pk2(val[6], val[7]);
        *(GAS v4u*)(TE + ((size_t)(g * 256 + n)) * 384 + kv * 8) = o; }
    for (int i = 0; i < 16; ++i) { const int v = tid + 512 * i, n = v >> 5, kv = v & 31, s = kv >> 1, hi0 = (kv & 1) * 8; float val[8];
#pragma unroll
        for (int j = 0; j < 8; ++j) { float x = 0.f;
            if (n < 128) { const int p = n & 63; const float a_r = Apr[(15 - s) * 64 + p], a_i = Api[(15 - s) * 64 + p], b_r = Bbr[p * 16 + hi0 + j], b_i = Bbi[p * 16 + hi0 + j];
                x = (n < 64) ? (a_r * b_r - a_i * b_i) : (a_r * b_i + a_i * b_r); }
            val[j] = x; }
        v4u o; o.x = pk2(val[0], val[1]); o.y = pk2(val[2], val[3]); o.z = pk2(val[4], val[5]); o.w = pk2(val[6], val[7]);
        *(GAS v4u*)(WP + ((size_t)(g * 256 + n)) * 256 + kv * 8) = o; }
    __syncthreads();
}

__device__ const unsigned char T5_BUCKET[128] = {0, 1, 2, 3, 4, 5, 6, 7, 8, 9, 10, 11, 12, 13, 14, 15, 16, 16, 16, 17, 17, 18, 18, 18, 19, 19, 19, 20, 20, 20, 20, 21, 21, 21, 21, 22, 22, 22, 22, 22, 23, 23, 23, 23, 23, 23, 24, 24, 24, 24, 24, 24,
    25, 25, 25, 25, 25, 25, 25, 26, 26, 26, 26, 26, 26, 26, 26, 27, 27, 27, 27, 27, 27, 27, 27, 27, 27, 28, 28, 28, 28, 28, 28, 28, 28, 28, 28, 29, 29, 29, 29, 29, 29, 29, 29, 29, 29, 29, 29, 30, 30, 30, 30, 30, 30, 30, 30, 30, 30, 30, 30, 30, 30,
    31, 31, 31, 31, 31, 31, 31, 31, 31, 31, 31, 31, 31, 31, 31};
constexpr int AT_KS = 0, AT_KSTRIDE = 144, AT_VT = 256 * 144, AT_VSTRIDE = 528, AT_BT = AT_VT + 64 * 528;
constexpr float NEGBIG = -1e30f;
__device__ __forceinline__ void attn_unit(LAS unsigned char* lds, int b, int nb, int kvh, const bf16* Qb, const bf16* KV, const float* btab, const float* sinks, bf16* ATT, float* RSA, int tid, int lane, int wave) {
    const int head = kvh * 8 + wave;
    for (int i = tid; i < 8 * 192; i += 512) { const int w = i / 192, n = (i - w * 192) - 32; float v = NEGBIG; if (n >= 0 && n < 128) v = btab[(int)T5_BUCKET[n] * 16 + kvh * 8 + w] * LOG2E; ((LAS float*)(lds + AT_BT))[i] = v; }
    const long tok0 = (long)b * SEQ + (long)nb * 128 - 128;
#pragma unroll
    for (int i = 0; i < 4; ++i) { const int idx = tid + 512 * i, row = idx >> 3, ch = idx & 7;
        if (nb > 0 || row >= 128) {
            const bf16* src = KV + (tok0 + row) * 256 + kvh * 64 + ch * 8;
            const v4u kv = *(const GAS v4u*)src; const v4u vv = *(const GAS v4u*)(src + 128);
            *(LAS v4u*)(lds + AT_KS + row * AT_KSTRIDE + ch * 16) = kv;
            const int pos = (row & ~12) | ((row & 4) << 1) | ((row & 8) >> 1);
            LAS bf16* vt = (LAS bf16*)(lds + AT_VT) + (ch * 8) * 264 + pos;
            vt[0 * 264] = (bf16)(vv.x & 0xffffu); vt[1 * 264] = (bf16)(vv.x >> 16); vt[2 * 264] = (bf16)(vv.y & 0xffffu); vt[3 * 264] = (bf16)(vv.y >> 16);
            vt[4 * 264] = (bf16)(vv.z & 0xffffu); vt[5 * 264] = (bf16)(vv.z >> 16); vt[6 * 264] = (bf16)(vv.w & 0xffffu); vt[7 * 264] = (bf16)(vv.w >> 16);
        } }
    __syncthreads();
    const int r = lane & 31, h = lane >> 5;
    const float sinkL2 = sinks[head] * LOG2E;
    const LAS float* bt = (const LAS float*)(lds + AT_BT) + wave * 192 + 32 + (r - 4 * h);
    for (int j = 0; j < 4; ++j) {
        const long qrow = (long)b * SEQ + nb * 128 + 32 * j + r;
        bf16x8 qf[4];
#pragma unroll
        for (int ds = 0; ds < 4; ++ds) qf[ds] = *(const GAS bf16x8*)(Qb + qrow * 1024 + head * 64 + 16 * ds + 8 * h);
        f32x16 S[5];
#pragma unroll
        for (int c = 0; c < 5; ++c) { const int kt = j + c; const bool valid = (nb > 0) || (kt >= 4);
            f32x16 a;
#pragma unroll
            for (int reg = 0; reg < 16; ++reg) a[reg] = 0.f;
            if (valid) {
#pragma unroll
                for (int ds = 0; ds < 4; ++ds) { const bf16x8 kf = *(const LAS bf16x8*)(lds + AT_KS + (32 * kt + r) * AT_KSTRIDE + (16 * ds + 8 * h) * 2); a = __builtin_amdgcn_mfma_f32_32x32x16_bf16(kf, qf[ds], a, 0, 0, 0); }
#pragma unroll
                for (int reg = 0; reg < 16; ++reg) a[reg] += bt[128 - 32 * c - ((reg & 3) + 8 * (reg >> 2))];
            } else {
#pragma unroll
                for (int reg = 0; reg < 16; ++reg) a[reg] = NEGBIG;
            }
            S[c] = a; }
        float mx = sinkL2;
#pragma unroll
        for (int c = 0; c < 5; ++c)
#pragma unroll
            for (int reg = 0; reg < 16; ++reg) mx = fmaxf(mx, S[c][reg]);
        mx = fmaxf(mx, __shfl_xor(mx, 32));
        float l = 0.f;
#pragma unroll
        for (int c = 0; c < 5; ++c)
#pragma unroll
            for (int reg = 0; reg < 16; ++reg) { const float p = __builtin_amdgcn_exp2f(S[c][reg] - mx); S[c][reg] = p; l += p; }
        l += __shfl_xor(l, 32); l += __builtin_amdgcn_exp2f(sinkL2 - mx);
        f32x16 o0, o1;
#pragma unroll
        for (int reg = 0; reg < 16; ++reg) { o0[reg] = 0.f; o1[reg] = 0.f; }
#pragma unroll
        for (int c = 0; c < 5; ++c) { const int kt = j + c; const bool valid = (nb > 0) || (kt >= 4);
            if (valid) {
#pragma unroll
                for (int s2 = 0; s2 < 2; ++s2) { v4u pw; pw.x = pg8::cvt_pk_bf16(S[c][8 * s2 + 0], S[c][8 * s2 + 1]); pw.y = pg8::cvt_pk_bf16(S[c][8 * s2 + 2], S[c][8 * s2 + 3]);
                    pw.z = pg8::cvt_pk_bf16(S[c][8 * s2 + 4], S[c][8 * s2 + 5]); pw.w = pg8::cvt_pk_bf16(S[c][8 * s2 + 6], S[c][8 * s2 + 7]);
                    const bf16x8 pf = __builtin_bit_cast(bf16x8, pw);
                    const bf16x8 v0 = *(const LAS bf16x8*)(lds + AT_VT + r * AT_VSTRIDE + (32 * kt + 16 * s2 + 8 * h) * 2);
                    const bf16x8 v1 = *(const LAS bf16x8*)(lds + AT_VT + (32 + r) * AT_VSTRIDE + (32 * kt + 16 * s2 + 8 * h) * 2);
                    o0 = __builtin_amdgcn_mfma_f32_32x32x16_bf16(v0, pf, o0, 0, 0, 0); o1 = __builtin_amdgcn_mfma_f32_32x32x16_bf16(v1, pf, o1, 0, 0, 0); }
            } }
        const float inv = 1.0f / l; float ss = 0.f;
        bf16* orow = ATT + qrow * 1024 + head * 64 + 4 * h;
#pragma unroll
        for (int g4 = 0; g4 < 4; ++g4) { const float a0 = o0[4 * g4] * inv, a1 = o0[4 * g4 + 1] * inv, a2 = o0[4 * g4 + 2] * inv, a3 = o0[4 * g4 + 3] * inv;
            const float c0 = o1[4 * g4] * inv, c1 = o1[4 * g4 + 1] * inv, c2 = o1[4 * g4 + 2] * inv, c3 = o1[4 * g4 + 3] * inv;
            ss += (a0 * a0 + a1 * a1) + (a2 * a2 + a3 * a3) + (c0 * c0 + c1 * c1) + (c2 * c2 + c3 * c3);
            v2u w0; w0.x = pg8::cvt_pk_bf16(a0, a1); w0.y = pg8::cvt_pk_bf16(a2, a3); v2u w1; w1.x = pg8::cvt_pk_bf16(c0, c1); w1.y = pg8::cvt_pk_bf16(c2, c3);
            *(GAS v2u*)(orow + 8 * g4) = w0; *(GAS v2u*)(orow + 32 + 8 * g4) = w1; }
        ss += __shfl_xor(ss, 32);
        if (h == 0) RSA[qrow * 16 + head] = ss;
    }
    __syncthreads();
}


__device__ __forceinline__ void ssm_carry(LAS unsigned char* lds, int L, const float* A16, const float* Sst, bf16* UX, int wave, int lane) {
    const int g = L >> 2, p = lane;
    const float a_r = A16[(g * 64 + p) * 2], a_i = A16[(g * 64 + p) * 2 + 1];
    const float* Sp = Sst + ((size_t)L * 256 + wave * 32) * 128 + p;
    float sr[32], si[32];
#pragma unroll
    for (int c = 0; c < 32; ++c) { sr[c] = Sp[(size_t)c * 128]; si[c] = Sp[(size_t)c * 128 + 64]; }
    float xr = 0.f, xi = 0.f;
#pragma unroll
    for (int c = 0; c < 32; ++c) { const float nr = a_r * xr - a_i * xi + sr[c], ni = a_r * xi + a_i * xr + si[c]; xr = nr; xi = ni; }
    LAS float* se = (LAS float*)lds;
    se[(wave * 64 + p) * 2] = xr; se[(wave * 64 + p) * 2 + 1] = xi;
    float br = a_r, bi = a_i;
#pragma unroll
    for (int k = 0; k < 5; ++k) { const float t = br * br - bi * bi; bi = 2.f * br * bi; br = t; }
    __syncthreads();
    float cr = 0.f, ci = 0.f;
    for (int v = 0; v < 7; ++v) if (v < wave) { const float er = se[(v * 64 + p) * 2], ei = se[(v * 64 + p) * 2 + 1]; const float nr = br * cr - bi * ci + er, ni = br * ci + bi * cr + ei; cr = nr; ci = ni; }
    bf16* Xp = UX + ((size_t)L * 256 + wave * 32) * 384 + 256 + p;
    xr = cr; xi = ci;
#pragma unroll
    for (int c = 0; c < 32; ++c) { Xp[(size_t)c * 384] = (bf16)f2bf(xr); Xp[(size_t)c * 384 + 64] = (bf16)f2bf(xi);
        const float nr = a_r * xr - a_i * xi + sr[c], ni = a_r * xi + a_i * xr + si[c]; xr = nr; xi = ni; }
}

constexpr int RT_ROWB = 528, RT_BUF = 96 * RT_ROWB, RT_LG = 2 * RT_BUF;
__device__ __forceinline__ void route_phase(LAS unsigned char* lds, int R0, const bf16* TB, const bf16* WrH, const bf16* WrL, const float* brg, const float* bre, gu32* ctl, unsigned* rec, unsigned* etok, float* ew, float* ers, int tid, int lane, int wave) {
    const int r = lane & 15, kq = lane >> 4;
    v4u st[6];
#define RT_LOAD(k0) do { _Pragma("unroll") for (int j = 0; j < 6; ++j) { const int q = tid + 512 * j, row96 = q >> 5, pc = q & 31; const bf16* src = (row96 < 48 ? WrH + (size_t)row96 * D : WrL + (size_t)(row96 - 48) * D) + (k0) + pc * 8; st[j] = *(const GAS v4u*)src; } } while (0)
#define RT_STORE(buf) do { _Pragma("unroll") for (int j = 0; j < 6; ++j) { const int q = tid + 512 * j, row96 = q >> 5, pc = q & 31; *(LAS v4u*)(lds + (buf) * RT_BUF + row96 * RT_ROWB + pc * 16) = st[j]; } } while (0)
    f32x4 acc[3];
#pragma unroll
    for (int cb = 0; cb < 3; ++cb) acc[cb] = (f32x4){0.f, 0.f, 0.f, 0.f};
    float ss = 0.f;
    const bf16* tp = TB + (size_t)(R0 + (wave & 3) * 16 + r) * D + kq * 8;
    v4u a_cur[8], a_nxt[8];
    RT_LOAD(0);
    if (wave < 4) {
#pragma unroll
        for (int ks = 0; ks < 8; ++ks) a_cur[ks] = *(const GAS v4u*)(tp + ks * 32);
    }
    RT_STORE(0);
    __syncthreads();
    for (int s = 0; s < 8; ++s) {
        if (s < 7) { RT_LOAD((s + 1) * 256);
            if (wave < 4) {
#pragma unroll
                for (int ks = 0; ks < 8; ++ks) a_nxt[ks] = *(const GAS v4u*)(tp + (s + 1) * 256 + ks * 32);
            } }
        if (wave < 4) { const LAS unsigned char* bb = lds + (s & 1) * RT_BUF + r * RT_ROWB + kq * 16;
#pragma unroll
            for (int ks = 0; ks < 8; ++ks) { const v4u aw = a_cur[ks]; const bf16x8 af = __builtin_bit_cast(bf16x8, aw);
                { const float e0 = pg8::bf_lo(aw.x), e1 = pg8::bf_hi(aw.x), e2 = pg8::bf_lo(aw.y), e3 = pg8::bf_hi(aw.y), e4 = pg8::bf_lo(aw.z), e5 = pg8::bf_hi(aw.z), e6 = pg8::bf_lo(aw.w), e7 = pg8::bf_hi(aw.w);
                  ss += (e0 * e0 + e1 * e1) + (e2 * e2 + e3 * e3) + (e4 * e4 + e5 * e5) + (e6 * e6 + e7 * e7); }
#pragma unroll
                for (int cb = 0; cb < 3; ++cb) { const bf16x8 bh = *(const LAS bf16x8*)(bb + (cb * 16) * RT_ROWB + ks * 64), bl = *(const LAS bf16x8*)(bb + (48 + cb * 16) * RT_ROWB + ks * 64);
                    acc[cb] = __builtin_amdgcn_mfma_f32_16x16x32_bf16(af, bh, acc[cb], 0, 0, 0); acc[cb] = __builtin_amdgcn_mfma_f32_16x16x32_bf16(af, bl, acc[cb], 0, 0, 0); } }
#pragma unroll
            for (int ks = 0; ks < 8; ++ks) a_cur[ks] = a_nxt[ks];
        }
        if (s < 7) RT_STORE((s + 1) & 1);
        __syncthreads();
    }
#undef RT_LOAD
#undef RT_STORE
    if (wave < 4) {
        ss += __shfl_xor(ss, 16); ss += __shfl_xor(ss, 32);
        LAS float* lg = (LAS float*)(lds + RT_LG) + wave * (16 * 48);
#pragma unroll
        for (int cb = 0; cb < 3; ++cb)
#pragma unroll
            for (int reg = 0; reg < 4; ++reg) lg[(kq * 4 + reg) * 48 + cb * 16 + r] = acc[cb][reg];
        LDS_WAIT(); asm volatile("" ::: "memory");
        if (lane < 16) { const int row = lane, token = R0 + wave * 16 + row; const float rstd = 1.f / sqrtf(ss * (1.f / D) + EPS); const LAS float* lr = lg + row * 48;
            float gl[4]; float gmax = -3.4e38f; int gi = 0;
#pragma unroll
            for (int j = 0; j < 4; ++j) { gl[j] = lr[j] * rstd + brg[j]; if (gl[j] > gmax) { gmax = gl[j]; gi = j; } }
            float gsum = 0.f;
#pragma unroll
            for (int j = 0; j < 4; ++j) gsum += __expf(gl[j] - gmax);
            const float gate = 1.f / gsum;
            float v0 = -3.4e38f, v1 = -3.4e38f; int i0 = 0, i1 = 0;
#pragma unroll
            for (int e = 0; e < 8; ++e) { const float v = lr[4 + gi * 8 + e] * rstd + bre[gi * 8 + e];
                if (v > v0) { v1 = v0; i1 = i0; v0 = v; i0 = e; } else if (v > v1) { v1 = v; i1 = e; } }
            const float w0 = gate / (1.f + __expf(v1 - v0)), w1 = gate - w0;
            const int E0 = gi * 8 + i0, E1 = gi * 8 + i1;
            const unsigned p0 = __hip_atomic_fetch_add(ctl + CW_CNT + 64 * E0, 1u, RLX_AGENT), p1 = __hip_atomic_fetch_add(ctl + CW_CNT + 64 * E1, 1u, RLX_AGENT);
            v4u a; a.x = (unsigned)E0; a.y = p0; a.z = (unsigned)E1; a.w = p1; *(GAS v4u*)(rec + (size_t)token * 4) = a;
            const unsigned i0x = (unsigned)E0 * 16384u + p0, i1x = (unsigned)E1 * 16384u + p1;
            etok[i0x] = (unsigned)token; etok[i1x] = (unsigned)token; ew[i0x] = w0; ew[i1x] = w1; ers[i0x] = rstd; ers[i1x] = rstd;
        }
    }
    __syncthreads();
}

struct Args { const float* in[27]; float* out; unsigned char* ws; };
#ifndef DUP_MASK
#define DUP_MASK 0
#endif
typedef __attribute__((address_space(4))) const char* kargp_t;
__device__ __forceinline__ const void* karg(int k) { kargp_t p = (kargp_t)__builtin_amdgcn_kernarg_segment_ptr(); asm volatile("" : "+s"(p)); return *(const void* const __attribute__((address_space(4)))*)(p + 8 * k); }
#define KIN(k) ((const float*)karg(k))
#define KOUT() ((float*)karg(27))
#define KWS(T, off) ((T*)((unsigned char*)karg(28) + (off)))
#define IDS() int tid = threadIdx.x; asm volatile("" : "+v"(tid)); const int lane = tid & 63; (void)lane
__global__ void __launch_bounds__(NWAVES * 64, 2) hymba_fwd(Args args_unused) {
    extern __shared__ __attribute__((aligned(16))) unsigned char lds[];
    Frame F;
    F.lds = (LAS unsigned char*)lds;
    F.MISC = (volatile LAS unsigned*)(F.lds + MISC_OFF);
    F.wave = __builtin_amdgcn_readfirstlane((int)threadIdx.x >> 6);
    F.G = gridDim.x; { const int bx = blockIdx.x; F.vcu = (F.G % 8 == 0) ? (bx % 8) * (F.G / 8) + bx / 8 : bx; }
    F.ctl = (gu32*)KWS(unsigned char, WS_CTL);
    for (int u = threadIdx.x; u < (LDS_BYTES - LDSCTL_OFF) / 4; u += NWAVES * 64) ((LAS unsigned*)(F.lds + LDSCTL_OFF))[u] = 0u;
    __syncthreads();
    (void)xcd_barrier_post((unsigned*)(F.ctl + CW_BAR), F.MISC + 8);
#define GRID_BAR() do { XcdBarrier b_; b_.bar = (unsigned*)KWS(unsigned, WS_CTL) + CW_BAR; b_.x = xb_xcc_id(); b_.st = F.MISC + 8; xcd_barrier(b_); } while (0)
    const int gw = F.vcu * NWAVES + F.wave, NGW = F.G * NWAVES;
    LAS int* tbl = (LAS int*)(F.lds + TB_OFF);

#if (DUP_MASK >> 0) & 1
_Pragma("unroll") for (int rep_ = 0; rep_ < 2; ++rep_)
#endif
    {
        IDS();
        if (F.vcu < 64) p0_ssm_tables(F, F.vcu, KIN(5), KIN(6), KIN(7), KIN(8), KIN(9), KIN(10), KIN(11), KIN(12), KWS(bf16, WS_TE), KWS(bf16, WS_WP), KWS(float, WS_SMALL + SM_A16));
        { const float* g_ffn = KIN(18); const float* wrg = KIN(19); const float* wre = KIN(21); bf16* WrH = KWS(bf16, WS_SMALL + SM_WRH); bf16* WrL = KWS(bf16, WS_SMALL + SM_WRL);
          const int gtid = F.vcu * 512 + tid, NGT = F.G * 512;
          for (int e = gtid; e < NRT * D; e += NGT) { const int j = e / D, k = e - j * D; float w = 0.f;
            if (j < 4) w = wrg[k * 4 + j]; else if (j < 36) w = wre[((size_t)((j - 4) >> 3) * D + k) * 8 + ((j - 4) & 7)];
            w *= g_ffn[k]; const unsigned hi = f2bf(w); WrH[e] = (bf16)hi; WrL[e] = (bf16)f2bf(w - bf2f(hi)); } }
        { LAS float* scr = (LAS float*)(F.lds + RING_OFF + F.wave * 16384);
          constexpr int IT_WIN = 32 * 72, IT_WGLU = 16 * 32, IT_WOUT = 32 * 64, IT_GU = 32 * 32 * 16, IT_DN = 32 * 8 * 64;
          constexpr int NITEMS = IT_WIN + IT_WGLU + IT_WOUT + 2 * IT_GU + IT_DN;
          const float* w_in = KIN(3); const float* w_glu = KIN(13); const float* w_out = KIN(17); const float* g_ffn = KIN(18); const float* w_gate = KIN(23); const float* w_up = KIN(24); const float* w_down = KIN(25);
          unsigned char* ws = KWS(unsigned char, 0);
          for (int it = gw; it < NITEMS; it += NGW) {
            int r = it;
            if (r < IT_WIN) { const int kb = r / 72, nb = r - kb * 72; p0_transpose_item(w_in, NPROJ, (bf16*)(ws + WS_WIN), D, (size_t)32 * nb, 64 * kb, 32 * nb, nullptr, scr, lane); continue; } r -= IT_WIN;
            if (r < IT_WGLU) { const int kb = r / 32, nb = r - kb * 32; p0_transpose_item(w_glu, DSSM, (bf16*)(ws + WS_WGLU), DSSM, (size_t)32 * nb, 64 * kb, 32 * nb, nullptr, scr, lane); continue; } r -= IT_WGLU;
            if (r < IT_WOUT) { const int kb = r / 64, nb = r - kb * 64; p0_transpose_item(w_out, D, (bf16*)(ws + WS_WOUT), D, (size_t)32 * nb, 64 * kb, 32 * nb, nullptr, scr, lane); continue; } r -= IT_WOUT;
            if (r < 2 * IT_GU) { const int up = r >= IT_GU ? 1 : 0; const int r2 = r - up * IT_GU, E = r2 >> 9, q = r2 & 511, kb = q >> 4, nb = q & 15, f0 = 32 * nb;
                const float* W = (up ? w_up : w_gate) + (size_t)E * D * DFF; const size_t drow0 = (size_t)E * 1024 + (f0 >> 7) * 256 + up * 128 + (f0 & 127);
                p0_transpose_item(W, DFF, (bf16*)(ws + WS_WGU), D, drow0, 64 * kb, f0, g_ffn, scr, lane); continue; } r -= 2 * IT_GU;
            { const int E = r >> 9, q = r & 511, kb = q >> 6, nb = q & 63; p0_transpose_item(w_down + (size_t)E * DFF * D, D, (bf16*)(ws + WS_WD), DFF, (size_t)E * D + 32 * nb, 64 * kb, 32 * nb, nullptr, scr, lane); }
          } }
        { const float* x = KIN(0); const float* g_mix = KIN(2); bf16* XN = KWS(bf16, WS_XN);
          for (int m = gw; m < M_TOK; m += NGW) rms_row_to_bf16(x + (size_t)m * D, g_mix, XN + (size_t)m * D, lane); }
        GRID_BAR();
    }
#if (DUP_MASK >> 1) & 1
_Pragma("unroll") for (int rep_ = 0; rep_ < 2; ++rep_)
#endif
    {
        IDS();
        unsigned char* ws = KWS(unsigned char, 0);
        pg8::StaticOrder S; S.init(M_TOK, NPROJ, F.G, (int)blockIdx.x);
        pg8::EpiInProj E{(bf16*)(ws + WS_Q), (bf16*)(ws + WS_KV), (bf16*)(ws + WS_UX)};
        pg8::gemm_phase<pg8::EpiInProj, pg8::StaticOrder, D, D, D>(F.lds + RING_OFF, (const bf16*)(ws + WS_XN), (const bf16*)(ws + WS_WIN), S, E);
        GRID_BAR();
    }
    {
        IDS();
        const int L = (int)blockIdx.x;
#if (DUP_MASK >> 2) & 1
_Pragma("unroll") for (int rep_ = 0; rep_ < 2; ++rep_)
#endif
        {
        { unsigned char* ws = KWS(unsigned char, 0); pg8::OneUnit S{L, L >> 2}; pg8::EpiS E{(float*)(ws + WS_S)};
          pg8::gemm_phase<pg8::EpiS, pg8::OneUnit, 256, 384, 256>(F.lds + RING_OFF, (const bf16*)(ws + WS_UX), (const bf16*)(ws + WS_WP), S, E); }
        { unsigned char* ws = KWS(unsigned char, 0); ssm_carry(F.lds + RING_OFF, L, (const float*)(ws + WS_SMALL + SM_A16), (const float*)(ws + WS_S), (bf16*)(ws + WS_UX), F.wave, lane); }
        VM_WAIT(); __syncthreads();
        { unsigned char* ws = KWS(unsigned char, 0); pg8::OneUnit S{L, L >> 2}; pg8::EpiY E{(bf16*)(ws + WS_YG)};
          pg8::gemm_phase<pg8::EpiY, pg8::OneUnit, 384, 384, 384>(F.lds + RING_OFF, (const bf16*)(ws + WS_UX), (const bf16*)(ws + WS_TE), S, E); }
        }
#if (DUP_MASK >> 3) & 1
_Pragma("unroll") for (int rep_ = 0; rep_ < 2; ++rep_)
#endif
        { unsigned char* ws = KWS(unsigned char, 0); const float* rel_bias = KIN(1); const float* sinks = KIN(4);
          attn_unit(F.lds + RING_OFF, L >> 6, (L >> 1) & 31, L & 1, (const bf16*)(ws + WS_Q), (const bf16*)(ws + WS_KV), rel_bias, sinks, (bf16*)(ws + WS_ATT), (float*)(ws + WS_RSA), tid, lane, F.wave); }
        GRID_BAR();
    }
#if (DUP_MASK >> 5) & 1
_Pragma("unroll") for (int rep_ = 0; rep_ < 2; ++rep_)
#endif
    {
        IDS();
        unsigned char* ws = KWS(unsigned char, 0);
        pg8::StaticOrder S; S.init(M_TOK, DSSM, F.G, (int)blockIdx.x);
        pg8::EpiGLU E{(const bf16*)(ws + WS_YG), KIN(14), (bf16*)(ws + WS_SG), (float*)(ws + WS_RSS)};
        pg8::gemm_phase<pg8::EpiGLU, pg8::StaticOrder, DSSM, DSSM, DSSM>(F.lds + RING_OFF, (const bf16*)(ws + WS_YG), (const bf16*)(ws + WS_WGLU), S, E);
        GRID_BAR();
    }
#if (DUP_MASK >> 6) & 1
_Pragma("unroll") for (int rep_ = 0; rep_ < 2; ++rep_)
#endif
    {
        IDS();
        unsigned char* ws = KWS(unsigned char, 0); const float* g_att = KIN(15); const float* g_ssm = KIN(16);
        const float* RSA = (const float*)(ws + WS_RSA); const float* RSS = (const float*)(ws + WS_RSS); const bf16* ATT = (const bf16*)(ws + WS_ATT); const bf16* SG = (const bf16*)(ws + WS_SG); bf16* MIX = (bf16*)(ws + WS_MIX);
        for (int m = gw; m < M_TOK; m += NGW) {
            float sa = RSA[(size_t)m * 16 + (lane & 15)], ss = RSS[(size_t)m * 16 + (lane & 15)];
#pragma unroll
            for (int o = 1; o < 16; o <<= 1) { sa += __shfl_xor(sa, o); ss += __shfl_xor(ss, o); }
            const float ra = 1.f / sqrtf(sa * (1.f / DATT) + EPS), rs = 1.f / sqrtf(ss * (1.f / DSSM) + EPS);
#pragma unroll
            for (int j = 0; j < 2; ++j) { const int idx = (lane + 64 * j) * 8;
                { const v4u a = *(const GAS v4u*)(ATT + (size_t)m * 1024 + idx); const f32x4 g0 = *(const GAS f32x4*)(g_att + idx), g1 = *(const GAS f32x4*)(g_att + idx + 4); v4u o;
                  o.x = pk2(pg8::bf_lo(a.x) * ra * g0.x, pg8::bf_hi(a.x) * ra * g0.y); o.y = pk2(pg8::bf_lo(a.y) * ra * g0.z, pg8::bf_hi(a.y) * ra * g0.w);
                  o.z = pk2(pg8::bf_lo(a.z) * ra * g1.x, pg8::bf_hi(a.z) * ra * g1.y); o.w = pk2(pg8::bf_lo(a.w) * ra * g1.z, pg8::bf_hi(a.w) * ra * g1.w);
                  *(GAS v4u*)(MIX + (size_t)m * D + idx) = o; }
                { const v4u a = *(const GAS v4u*)(SG + (size_t)m * 1024 + idx); const f32x4 g0 = *(const GAS f32x4*)(g_ssm + idx), g1 = *(const GAS f32x4*)(g_ssm + idx + 4); v4u o;
                  o.x = pk2(pg8::bf_lo(a.x) * rs * g0.x, pg8::bf_hi(a.x) * rs * g0.y); o.y = pk2(pg8::bf_lo(a.y) * rs * g0.z, pg8::bf_hi(a.y) * rs * g0.w);
                  o.z = pk2(pg8::bf_lo(a.z) * rs * g1.x, pg8::bf_hi(a.z) * rs * g1.y); o.w = pk2(pg8::bf_lo(a.w) * rs * g1.z, pg8::bf_hi(a.w) * rs * g1.w);
                  *(GAS v4u*)(MIX + (size_t)m * D + 1024 + idx) = o; } } }
        GRID_BAR();
    }
#if (DUP_MASK >> 7) & 1
_Pragma("unroll") for (int rep_ = 0; rep_ < 2; ++rep_)
#endif
    {
        IDS();
        unsigned char* ws = KWS(unsigned char, 0);
        pg8::StaticOrder S; S.init(M_TOK, D, F.G, (int)blockIdx.x); pg8::EpiXmid E{KIN(0), (bf16*)(ws + WS_TB)};
        pg8::gemm_phase<pg8::EpiXmid, pg8::StaticOrder, D, D, D>(F.lds + RING_OFF, (const bf16*)(ws + WS_MIX), (const bf16*)(ws + WS_WOUT), S, E);
        GRID_BAR();
    }
#if (DUP_MASK >> 8) & 1
_Pragma("unroll") for (int rep8_ = 0; rep8_ < 2; ++rep8_)
#else
    constexpr int rep8_ = 1;
#endif
    {
        IDS();
        unsigned char* ws = KWS(unsigned char, 0); const float* brg = KIN(20); const float* bre = KIN(22);
        const size_t doff = rep8_ ? 0 : (WS_O - WS_ROUTE);
        for (int blk = blockIdx.x; blk < M_TOK / 64; blk += F.G) route_phase(F.lds + RING_OFF, blk * 64, (const bf16*)(ws + WS_TB), (const bf16*)(ws + WS_SMALL + SM_WRH), (const bf16*)(ws + WS_SMALL + SM_WRL), brg, bre, F.ctl + (rep8_ ? 0 : 4096),
            (unsigned*)(ws + WS_ROUTE + doff + RT_REC), (unsigned*)(ws + WS_ROUTE + doff + RT_ETOK), (float*)(ws + WS_ROUTE + doff + RT_EW), (float*)(ws + WS_ROUTE + doff + RT_ERS), tid, lane, F.wave);
        GRID_BAR();
    }
    {
        IDS();
        if (tid == 0) { int acc = 0; for (int e = 0; e < 32; ++e) { tbl[e] = acc; acc += (int)((__hip_atomic_load(F.ctl + CW_CNT + 64 * e, RLX_AGENT) + 255u) >> 8); } tbl[32] = acc; }
        __syncthreads();
        LAS int* gidx = (LAS int*)(F.lds + GIDX_OFF);
        { const unsigned* ETOK = KWS(unsigned, WS_ROUTE + RT_ETOK); pg8::MoeOrder S{tbl, 4, F.G, (int)blockIdx.x};
          for (int j = 0; j < 8; ++j) { pg8::Unit u; if (!S.next(j, u)) break; const int Ex = u.pn >> 2, mt = u.pm - tbl[Ex]; const int cntE = (int)__hip_atomic_load(F.ctl + CW_CNT + 64 * Ex, RLX_AGENT);
              if (tid < 256) { const int pos = mt * 256 + tid; gidx[j * 256 + tid] = pos < cntE ? (int)ETOK[(size_t)Ex * 16384 + pos] : 0; } }
          __syncthreads(); }
#if (DUP_MASK >> 10) & 1
_Pragma("unroll") for (int rep_ = 0; rep_ < 2; ++rep_)
#endif
        {
        IDS();
        unsigned char* ws = KWS(unsigned char, 0);
        pg8::MoeOrder S{tbl, 4, F.G, (int)blockIdx.x};
        pg8::EpiSwiGLU E{(const float*)(ws + WS_ROUTE + RT_ERS), (const float*)(ws + WS_ROUTE + RT_EW), (bf16*)(ws + WS_HID), tbl};
        pg8::gemm_phase<pg8::EpiSwiGLU, pg8::MoeOrder, D, D, D, true>(F.lds + RING_OFF, (const bf16*)(ws + WS_TB), (const bf16*)(ws + WS_WGU), S, E, gidx);
        GRID_BAR();
        }
    }
#if (DUP_MASK >> 11) & 1
_Pragma("unroll") for (int rep_ = 0; rep_ < 2; ++rep_)
#endif
    {
        IDS();
        unsigned char* ws = KWS(unsigned char, 0);
        pg8::MoeOrder S{tbl, 8, F.G, (int)blockIdx.x}; pg8::EpiDown E{(bf16*)(ws + WS_O)};
        pg8::gemm_phase<pg8::EpiDown, pg8::MoeOrder, DFF, DFF, DFF>(F.lds + RING_OFF, (const bf16*)(ws + WS_HID), (const bf16*)(ws + WS_WD), S, E);
        GRID_BAR();
    }
#if (DUP_MASK >> 12) & 1
_Pragma("unroll") for (int rep12_ = 0; rep12_ < 2; ++rep12_)
#endif
    {
        IDS();
        float* outp = KOUT(); const float* g_final = KIN(26);
        unsigned char* ws = KWS(unsigned char, 0); const unsigned* REC = (const unsigned*)(ws + WS_ROUTE + RT_REC); const bf16* OB = (const bf16*)(ws + WS_O); const bf16* TBp = (const bf16*)(ws + WS_TB);
        for (int m0 = gw; m0 < M_TOK; m0 += 2 * NGW) {
            f32x4 v[2][8]; float s[2];
#pragma unroll
            for (int q = 0; q < 2; ++q) { const int m = m0 + q * NGW;
                const v4u rc = *(const GAS v4u*)(REC + (size_t)m * 4);
                const unsigned s0 = (unsigned)tbl[rc.x] * 256u + rc.y, s1 = (unsigned)tbl[rc.z] * 256u + rc.w;
                const GAS v2u* xr = (const GAS v2u*)(TBp + (size_t)m * D) + lane; const GAS v2u* o0 = (const GAS v2u*)(OB + (size_t)s0 * D) + lane; const GAS v2u* o1 = (const GAS v2u*)(OB + (size_t)s1 * D) + lane;
                s[q] = 0.f;
#pragma unroll
                for (int j = 0; j < 8; ++j) { const v2u xw = xr[64 * j], a = o0[64 * j], c = o1[64 * j];
                    v[q][j].x = pg8::bf_lo(xw.x) + pg8::bf_lo(a.x) + pg8::bf_lo(c.x); v[q][j].y = pg8::bf_hi(xw.x) + pg8::bf_hi(a.x) + pg8::bf_hi(c.x);
                    v[q][j].z = pg8::bf_lo(xw.y) + pg8::bf_lo(a.y) + pg8::bf_lo(c.y); v[q][j].w = pg8::bf_hi(xw.y) + pg8::bf_hi(a.y) + pg8::bf_hi(c.y);
                    s[q] += dot4(v[q][j]); } }
#pragma unroll
            for (int q = 0; q < 2; ++q) { const int m = m0 + q * NGW; const float rstd = 1.f / sqrtf(wave_sum(s[q]) * (1.f / D) + EPS);
                GAS f32x4* orow = (GAS f32x4*)(outp + (size_t)m * D) + lane;
#pragma unroll
                for (int j = 0; j < 8; ++j) { const f32x4 gv = ((const GAS f32x4*)g_final)[lane + 64 * j]; orow[64 * j] = v[q][j] * rstd * gv; } }
        }
#if (DUP_MASK >> 12) & 1
        GRID_BAR();
#endif
    }
}

extern "C" void kernel_launch(void* const* d_in, const int* in_sizes, int n_in, void* d_out, int out_size, void* d_ws, size_t ws_size, hipStream_t stream) {
    static int grid = 0;
    if (grid == 0) {
        if (n_in != 27 || in_sizes[0] != M_TOK * D || out_size != M_TOK * D || ws_size < WS_END) { fprintf(stderr, "kernel_launch: unexpected shapes (n_in %d, in0 %d, out %d, ws %zu < %zu)\n", n_in, n_in > 0 ? in_sizes[0] : -1, out_size, ws_size, (size_t)WS_END); grid = -1; return; }
        int dev = 0, cus = 0, per_cu = 0;
        if (hipGetDevice(&dev) != hipSuccess || hipDeviceGetAttribute(&cus, hipDeviceAttributeMultiprocessorCount, dev) != hipSuccess) { grid = -1; return; }
        if (hipFuncSetAttribute((const void*)hymba_fwd, hipFuncAttributeMaxDynamicSharedMemorySize, LDS_BYTES) != hipSuccess) { fprintf(stderr, "kernel_launch: hipFuncSetAttribute failed\n"); grid = -1; return; }
        if (hipOccupancyMaxActiveBlocksPerMultiprocessor(&per_cu, (const void*)hymba_fwd, NWAVES * 64, LDS_BYTES) != hipSuccess || per_cu < 1)
            fprintf(stderr, "kernel_launch: note: occupancy query reports %d workgroups per CU\n", per_cu);
        (void)hipGetLastError();
        if (cus != 256) { fprintf(stderr, "kernel_launch: built for a 256-CU device (one workgroup per CU, 256 SSM / attention units), found %d\n", cus); grid = -1; return; }
        grid = cus;
    }
    if (grid < 0) return;
    if (hipMemsetAsync((char*)d_ws + WS_CTL, 0, CTL_ZERO_BYTES, stream) != hipSuccess) return;
    Args a{};
    for (int i = 0; i < 27; ++i) a.in[i] = (const float*)d_in[i];
    a.out = (float*)d_out; a.ws = (unsigned char*)d_ws;
    hipLaunchKernelGGL(hymba_fwd, dim3(grid), dim3(NWAVES * 64), LDS_BYTES, stream, a);
}
```

```cpp
#include <hip/hip_runtime.h>
#include <cstdio>
#include <cstdint>
namespace pg8 {
#define PG8_LAS __attribute__((address_space(3)))
typedef unsigned short bf16_t;
typedef short bf16x8 __attribute__((ext_vector_type(8)));
typedef float f32x4 __attribute__((ext_vector_type(4)));
typedef float f32x2 __attribute__((ext_vector_type(2)));
typedef unsigned u32x4 __attribute__((ext_vector_type(4)));
typedef unsigned u32x2 __attribute__((ext_vector_type(2)));
constexpr int BM = 256, BK = 64, HALF = 128, HTB = HALF * BK * 2  , STAGE_BYTES = 8 * HTB, NXCD = 8, WGM = 8;

__host__ __device__ __forceinline__ int lds_byte(int r, int c) { const int st = (r >> 4) * 2 + (c >> 5), rr = r & 15, cc = c & 31, ob = rr * 64 + cc * 2; return st * 1024 + (ob ^ (((ob >> 9) & 1) << 5)); }
__host__ __device__ __forceinline__ void stage_rc(int b, int& R, int& C) { const int st = b / 1024, sb = b % 1024, swz = sb ^ (((sb >> 9) & 1) << 5); R = (st >> 1) * 16 + swz / 64; C = (st & 1) * 32 + (swz % 64) / 2; }
__host__ __device__ __forceinline__ int perm32(int rho) { const int n = rho >> 4, i = rho & 15; return 8 * (i >> 2) + 4 * n + (i & 3); }

struct Unit { int pm, pn, ord; };

struct StaticOrder {
    int nM, nN, nwg, G, c, nx;
    __host__ __device__ void init(int M, int N, int G_, int c_, int nx_ = NXCD) { nM = M / BM; nN = N / BM; nwg = nM * nN; G = G_; c = c_; nx = nx_; }
    __host__ __device__ bool next(int i, Unit& u) const {
        const long L = (long)i * G + c; if (L >= nwg) return false;
        int wgid = (int)L; { const int q = nwg / nx, r = nwg % nx, xcd = wgid % nx, off = wgid / nx; wgid = (xcd < r ? xcd * (q + 1) : r * (q + 1) + (xcd - r) * q) + off; }
        const int nig = WGM * nN, gid = wgid / nig, fm = gid * WGM, gsz = (nM - fm) < WGM ? (nM - fm) : WGM;
        u.pm = fm + ((wgid % nig) % gsz); u.pn = (wgid % nig) / gsz; return true;
    }
    __device__ __forceinline__ void a_ready(const Unit&) const {}
    __device__ __forceinline__ void done(const Unit&) const {}
};
struct OneUnit {
    int pm, pn;
    __device__ bool next(int i, Unit& u) const { if (i > 0) return false; u.pm = pm; u.pn = pn; return true; }
};
struct MoeOrder {
    const PG8_LAS int* tb; int ntn, G, c;
    __device__ bool next(int i, Unit& u) const {
        const int L = i * G + c, NT = tb[32]; if (L >= NT * ntn) return false;
        const int tt = L / ntn, nt = L - tt * ntn; int E = 0;
#pragma unroll
        for (int e = 1; e < 32; ++e) E += (tt >= tb[e]) ? 1 : 0;
        u.pm = tt; u.pn = __builtin_amdgcn_readfirstlane(E * ntn + nt); return true;
    }
};

__device__ __forceinline__ int lane_id_() { int l; asm volatile("v_mbcnt_lo_u32_b32 %0, -1, 0\n\tv_mbcnt_hi_u32_b32 %0, -1, %0" : "=v"(l)); return l; }
__device__ __forceinline__ unsigned cvt_pk_bf16(float lo, float hi) { unsigned r; asm volatile("v_cvt_pk_bf16_f32 %0, %1, %2" : "=v"(r) : "v"(lo), "v"(hi)); return r; }
__device__ __forceinline__ u32x4 pack8(const f32x4 a, const f32x4 b) { u32x4 w; w.x = cvt_pk_bf16(a[0], a[1]); w.y = cvt_pk_bf16(a[2], a[3]); w.z = cvt_pk_bf16(b[0], b[1]); w.w = cvt_pk_bf16(b[2], b[3]); return w; }
__device__ __forceinline__ float bf_lo(unsigned w) { return __uint_as_float(w << 16); }
__device__ __forceinline__ float bf_hi(unsigned w) { return __uint_as_float(w & 0xffff0000u); }
__device__ __forceinline__ float sigmoidf_(float v) { return __builtin_amdgcn_rcpf(1.0f + __builtin_amdgcn_exp2f(-1.4426950408889634f * v)); }
__device__ __forceinline__ float gelu_tanh_(float v) { const float z = v + 0.044715f * v * v * v; return v * __builtin_amdgcn_rcpf(1.0f + __builtin_amdgcn_exp2f(-2.3022081982f * z)); }

constexpr float QSCALE = 0.125f * 1.4426950408889634f;

struct EpiInProj {
    static constexpr bool PERM = true, MIDK = false;
    bf16_t* Q; bf16_t* KV; bf16_t* UX;
    __device__ __forceinline__ void operator()(const f32x4 (&acc)[2][2][4][2], const Unit& u, int wr, int wc, int fr, int fq) const {
        const int row0 = u.pm * BM + wr * 64 + fr, cw = wc * 32 + 8 * fq;
#pragma unroll
        for (int ai = 0; ai < 2; ++ai)
#pragma unroll
            for (int m = 0; m < 4; ++m) { const int row = row0 + ai * HALF + m * 16;
#pragma unroll
                for (int bj = 0; bj < 2; ++bj) { f32x4 v0 = acc[ai][bj][m][0], v1 = acc[ai][bj][m][1]; const int ct = bj * HALF + cw;
                    if (u.pn < 4) { v0 = v0 * QSCALE; v1 = v1 * QSCALE; *(u32x4*)(Q + (size_t)row * 1024 + u.pn * 256 + ct) = pack8(v0, v1); }
                    else if (u.pn == 4) { *(u32x4*)(KV + (size_t)row * 256 + ct) = pack8(v0, v1); }
                    else { const int ch = (u.pn - 5) * 256 + ct, g = ch >> 4, hi0 = ch & 15;
                        *(u32x4*)(UX + ((size_t)(g * 1024 + (row >> 4)) * 384 + (row & 15) * 16 + hi0)) = pack8(v0, v1); } } }
    }
};
struct EpiS {
    static constexpr bool PERM = false, MIDK = false;
    float* S;
    __device__ __forceinline__ void operator()(const f32x4 (&acc)[2][2][4][2], const Unit& u, int wr, int wc, int fr, int fq) const {
        const int row0 = u.pm * BM + wr * 64 + fr, col0 = wc * 32 + 4 * fq;
#pragma unroll
        for (int ai = 0; ai < 2; ++ai)
#pragma unroll
            for (int m = 0; m < 4; ++m) { float* rowp = S + (size_t)(row0 + ai * HALF + m * 16) * 128 + col0;
#pragma unroll
                for (int n = 0; n < 2; ++n) *(f32x4*)(rowp + n * 16) = acc[ai][0][m][n]; }
    }
};
struct EpiY {
    static constexpr bool PERM = true, MIDK = false;
    bf16_t* YG;
    __device__ __forceinline__ void operator()(const f32x4 (&acc)[2][2][4][2], const Unit& u, int wr, int wc, int fr, int fq) const {
        const int g = u.pm >> 2, s0 = (u.pm & 3) * 256 + wr * 64 + fr, cw = wc * 32 + 8 * fq;
#pragma unroll
        for (int ai = 0; ai < 2; ++ai)
#pragma unroll
            for (int m = 0; m < 4; ++m) { const int stream = s0 + ai * HALF + m * 16;
#pragma unroll
                for (int bj = 0; bj < 2; ++bj) { const int n = bj * HALF + cw, tau = n >> 4, ho0 = n & 15; f32x4 v0 = acc[ai][bj][m][0], v1 = acc[ai][bj][m][1];
#pragma unroll
                    for (int e = 0; e < 4; ++e) { v0[e] = gelu_tanh_(v0[e]); v1[e] = gelu_tanh_(v1[e]); }
                    *(u32x4*)(YG + (size_t)(stream * 16 + tau) * 1024 + g * 16 + ho0) = pack8(v0, v1); } }
    }
};
struct EpiGLU {
    static constexpr bool PERM = true, MIDK = false;
    const bf16_t* YG; const float* bias; bf16_t* SG; float* RS;
    __device__ __forceinline__ void operator()(const f32x4 (&acc)[2][2][4][2], const Unit& u, int wr, int wc, int fr, int fq) const {
        const int row0 = u.pm * BM + wr * 64 + fr, col0 = u.pn * BM + wc * 32 + 8 * fq;
        f32x4 bv[2][2];
#pragma unroll
        for (int bj = 0; bj < 2; ++bj)
#pragma unroll
            for (int n = 0; n < 2; ++n) bv[bj][n] = *(const f32x4*)(bias + col0 + bj * HALF + 4 * n);
#pragma unroll
        for (int ai = 0; ai < 2; ++ai)
#pragma unroll
            for (int m = 0; m < 4; ++m) { const int row = row0 + ai * HALF + m * 16; float ss = 0.f;
#pragma unroll
                for (int bj = 0; bj < 2; ++bj) { const size_t off = (size_t)row * 1024 + col0 + bj * HALF, offs = (size_t)row * 2048 + 1024 + col0 + bj * HALF; const u32x4 yw = *(const u32x4*)(YG + off);
                    const f32x4 a0 = acc[ai][bj][m][0] + bv[bj][0], a1 = acc[ai][bj][m][1] + bv[bj][1]; f32x4 o0, o1;
                    o0[0] = bf_lo(yw.x) * sigmoidf_(a0[0]); o0[1] = bf_hi(yw.x) * sigmoidf_(a0[1]); o0[2] = bf_lo(yw.y) * sigmoidf_(a0[2]); o0[3] = bf_hi(yw.y) * sigmoidf_(a0[3]);
                    o1[0] = bf_lo(yw.z) * sigmoidf_(a1[0]); o1[1] = bf_hi(yw.z) * sigmoidf_(a1[1]); o1[2] = bf_lo(yw.w) * sigmoidf_(a1[2]); o1[3] = bf_hi(yw.w) * sigmoidf_(a1[3]);
                    ss += (o0[0] * o0[0] + o0[1] * o0[1]) + (o0[2] * o0[2] + o0[3] * o0[3]) + (o1[0] * o1[0] + o1[1] * o1[1]) + (o1[2] * o1[2] + o1[3] * o1[3]);
                    *(u32x4*)(SG + offs) = pack8(o0, o1); }
                ss += __shfl_xor(ss, 16); ss += __shfl_xor(ss, 32);
                if (fq == 0) RS[(size_t)row * 16 + u.pn * 4 + wc] = ss; }
    }
};
struct EpiXmid {
    static constexpr bool PERM = true, MIDK = true;
    const float* X; bf16_t* T; const PG8_LAS f32x2* sc;
    __device__ __forceinline__ void midk(f32x4 (&acc)[2][2][4][2], const Unit& u, int wr, int fr) const {
#pragma unroll
        for (int ai = 0; ai < 2; ++ai)
#pragma unroll
            for (int m = 0; m < 4; ++m) { const float q = sc[u.ord * 256 + ai * HALF + wr * 64 + m * 16 + fr].x;
#pragma unroll
                for (int bj = 0; bj < 2; ++bj)
#pragma unroll
                    for (int n = 0; n < 2; ++n) acc[ai][bj][m][n] = acc[ai][bj][m][n] * q; }
    }
    __device__ __forceinline__ void operator()(const f32x4 (&acc)[2][2][4][2], const Unit& u, int wr, int wc, int fr, int fq) const {
        const int row0 = u.pm * BM + wr * 64 + fr, col0 = u.pn * BM + wc * 32 + 8 * fq;
#pragma unroll
        for (int ai = 0; ai < 2; ++ai)
#pragma unroll
            for (int m = 0; m < 4; ++m) { const size_t off = (size_t)(row0 + ai * HALF + m * 16) * 2048 + col0; const float rs = sc[u.ord * 256 + ai * HALF + wr * 64 + m * 16 + fr].y;
#pragma unroll
                for (int bj = 0; bj < 2; ++bj) { const size_t o = off + bj * HALF; const f32x4 x0 = *(const f32x4*)(X + o), x1 = *(const f32x4*)(X + o + 4);
                    *(u32x4*)(T + o) = pack8(x0 + acc[ai][bj][m][0] * rs, x1 + acc[ai][bj][m][1] * rs); } }
    }
};
struct EpiSwiGLU {
    static constexpr bool PERM = true, MIDK = false;
    const float* ers; const float* ew; bf16_t* HID; const PG8_LAS int* tb;
    __device__ __forceinline__ void operator()(const f32x4 (&acc)[2][2][4][2], const Unit& u, int wr, int wc, int fr, int fq) const {
        const int Ex = u.pn >> 2, lb = Ex * 16384 + (u.pm - tb[Ex]) * 256 + wr * 64 + fr;
        const int row0 = u.pm * BM + wr * 64 + fr, col0 = (u.pn & 3) * 128 + wc * 32 + 8 * fq;
#pragma unroll
        for (int ai = 0; ai < 2; ++ai)
#pragma unroll
            for (int m = 0; m < 4; ++m) { const int slot = row0 + ai * HALF + m * 16, li = lb + ai * HALF + m * 16; const float rs = ers[li], w = ew[li]; f32x4 o[2];
#pragma unroll
                for (int n = 0; n < 2; ++n)
#pragma unroll
                    for (int e = 0; e < 4; ++e) { const float gt = acc[ai][0][m][n][e] * rs, up = acc[ai][1][m][n][e] * rs; o[n][e] = gt * sigmoidf_(gt) * up * w; }
                *(u32x4*)(HID + (size_t)slot * 512 + col0) = pack8(o[0], o[1]); }
    }
};
struct EpiDown {
    static constexpr bool PERM = true, MIDK = false;
    bf16_t* O;
    __device__ __forceinline__ void operator()(const f32x4 (&acc)[2][2][4][2], const Unit& u, int wr, int wc, int fr, int fq) const {
        const int row0 = u.pm * BM + wr * 64 + fr, col0 = (u.pn & 7) * 256 + wc * 32 + 8 * fq;
#pragma unroll
        for (int ai = 0; ai < 2; ++ai)
#pragma unroll
            for (int m = 0; m < 4; ++m) { bf16_t* rowp = O + (size_t)(row0 + ai * HALF + m * 16) * 2048 + col0;
#pragma unroll
                for (int bj = 0; bj < 2; ++bj) *(u32x4*)(rowp + bj * HALF) = pack8(acc[ai][bj][m][0], acc[ai][bj][m][1]); }
    }
};

template <class Epi, class Sched, int K, int LDA, int LDB, bool GATHER = false>
__device__ __forceinline__ void gemm_phase(PG8_LAS unsigned char* lds, int wave_id, const bf16_t* Ab, const bf16_t* Bb, const Sched& S, const Epi& E, const PG8_LAS int* gidx = nullptr) {
    int tid_ = wave_id * 64 + lane_id_(); asm volatile("" : "+v"(tid_));
    const int tid = tid_, wid = wave_id, lane = tid & 63, wr = wid >> 2, wc = wid & 3, fr = lane & 15, fq = lane >> 4;
    constexpr int nt = K / BK;
    static_assert(K % 128 == 0 && K >= 256, "K multiple of 128, >= 256");
    unsigned voffA[2], voffB[2], voffG[2][2];
#pragma unroll
    for (int i = 0; i < 2; ++i) { int R, C; stage_rc(tid * 16 + i * 8192, R, C); const int Rb = Epi::PERM ? ((R & ~31) + perm32(R & 31)) : R;
        voffA[i] = (unsigned)(R * LDA + C) * 2u; voffB[i] = (unsigned)(Rb * LDB + C) * 2u; voffG[0][i] = 0u; voffG[1][i] = 0u; }
    constexpr size_t kstep = (size_t)(BK * 2);
    constexpr size_t hstepA = GATHER ? 0 : (size_t)HALF * LDA * 2, hstepB = (size_t)HALF * LDB * 2;
    constexpr size_t tstepA = 2 * hstepA, tstepB = 2 * hstepB;
    const unsigned ldsw = (unsigned)wid * 1024u;
    const int aoff = lds_byte(wr * 64 + fr, fq * 8), boff = lds_byte(wc * 32 + fr, fq * 8);
#define PG8_SA(b, h) (((b) * 2 + (h)) * HTB)
#define PG8_SB(b, h) ((4 + (b) * 2 + (h)) * HTB)
#define PG8_STAGE(bufoff, gbase, voff) do { _Pragma("unroll") for (int _i = 0; _i < 2; ++_i) \
        __builtin_amdgcn_global_load_lds((const unsigned*)((const char*)(gbase) + (voff)[_i]), (PG8_LAS unsigned*)(lds + (bufoff) + ldsw + _i * 8192), 16, 0, 0); } while (0)
#define PG8_STA(b, h, ptr) do { if constexpr (GATHER) PG8_STAGE(PG8_SA(b, h), ptr, voffG[h]); else PG8_STAGE(PG8_SA(b, h), (ptr) + (h) * hstepA, voffA); } while (0)
#define PG8_LOADG(uord) do { _Pragma("unroll") for (int _h = 0; _h < 2; ++_h) _Pragma("unroll") for (int _i = 0; _i < 2; ++_i) { int R_, C_; stage_rc(tid * 16 + _i * 8192, R_, C_); \
        const int tok_ = gidx[(uord) * 256 + _h * 128 + R_]; voffG[_h][_i] = (unsigned)(tok_ * LDA + C_) * 2u; } } while (0)
#define PG8_LDA(dst, b, h) do { _Pragma("unroll") for (int m = 0; m < 4; ++m) _Pragma("unroll") for (int k = 0; k < 2; ++k) dst[m][k] = *(const PG8_LAS bf16x8*)(lds + PG8_SA(b, h) + aoff + m * 2048 + k * 1024); } while (0)
#define PG8_LDB(dst, b, h) do { _Pragma("unroll") for (int n = 0; n < 2; ++n) _Pragma("unroll") for (int k = 0; k < 2; ++k) dst[n][k] = *(const PG8_LAS bf16x8*)(lds + PG8_SB(b, h) + boff + n * 2048 + k * 1024); } while (0)
#define PG8_MMA(ai, bj, At, Bt) do { __builtin_amdgcn_s_setprio(1); _Pragma("unroll") for (int m = 0; m < 4; ++m) _Pragma("unroll") for (int n = 0; n < 2; ++n) _Pragma("unroll") for (int k = 0; k < 2; ++k) \
        acc[ai][bj][m][n] = __builtin_amdgcn_mfma_f32_16x16x32_bf16(Bt[n][k], At[m][k], acc[ai][bj][m][n], 0, 0, 0); __builtin_amdgcn_s_setprio(0); } while (0)
#define PG8_WAIT_V(n) asm volatile("s_waitcnt vmcnt(" #n ")" ::: "memory")
#define PG8_WAIT_L(n) asm volatile("s_waitcnt lgkmcnt(" #n ")" ::: "memory")
#define PG8_BAR __builtin_amdgcn_s_barrier()
#define PG8_SCHED __builtin_amdgcn_sched_barrier(0)
    Unit cur, nxt; int ui = 0;
    if (!S.next(0, cur)) return;
    cur.ord = 0;
    f32x4 acc[2][2][4][2];
#pragma unroll
    for (int a = 0; a < 2; ++a)
#pragma unroll
        for (int b = 0; b < 2; ++b)
#pragma unroll
            for (int m = 0; m < 4; ++m)
#pragma unroll
                for (int n = 0; n < 2; ++n) acc[a][b][m][n] = (f32x4){0.f, 0.f, 0.f, 0.f};
    bf16x8 At[4][2], B0[2][2], B1[2][2];
    const char* cA = (const char*)Ab + (size_t)cur.pm * tstepA; const char* cB = (const char*)Bb + (size_t)cur.pn * tstepB;
    if constexpr (GATHER) { PG8_LOADG(0); }
    PG8_STAGE(PG8_SB(0, 0), cB, voffB); PG8_STAGE(PG8_SB(0, 1), cB + hstepB, voffB); PG8_STA(0, 0, cA); PG8_STA(0, 1, cA);
    if (wr == 1) PG8_BAR;
    PG8_WAIT_V(2); PG8_BAR;
    PG8_STAGE(PG8_SB(1, 0), cB + kstep, voffB); PG8_STA(1, 0, cA + kstep); PG8_STAGE(PG8_SB(1, 1), cB + hstepB + kstep, voffB);
    PG8_WAIT_V(6); PG8_BAR;
    for (;;) {
        const bool has_next = S.next(ui + 1, nxt); nxt.ord = ui + 1;
        const char* nA = has_next ? (const char*)Ab + (size_t)nxt.pm * tstepA : cA; const char* nB = has_next ? (const char*)Bb + (size_t)nxt.pn * tstepB : cB;
        for (int t = 0; t < nt; t += 2) {
            const bool last = (t == nt - 2);
            const char* a1 = cA + (size_t)(t + 1) * kstep;
            const char* a2 = last ? nA : cA + (size_t)(t + 2) * kstep; const char* b2 = last ? nB : cB + (size_t)(t + 2) * kstep;
            const char* a3 = a2 + kstep; const char* b3 = b2 + kstep;
            if constexpr (Epi::MIDK) { if (t == nt / 2) E.midk(acc, cur, wr, fr); }
            PG8_LDB(B0, 0, 0); PG8_LDB(B1, 0, 1); PG8_SCHED; PG8_LDA(At, 0, 0); PG8_STA(1, 1, a1);
            if constexpr (GATHER) { if (last && has_next) { PG8_LOADG(ui + 1); } }
            PG8_WAIT_V(8); PG8_WAIT_L(0); PG8_BAR; PG8_MMA(0, 0, At, B0); PG8_MMA(0, 1, At, B1); PG8_BAR; PG8_SCHED;
            PG8_LDA(At, 0, 1); PG8_STAGE(PG8_SB(0, 0), b2, voffB); PG8_STAGE(PG8_SB(0, 1), b2 + hstepB, voffB); PG8_STA(0, 0, a2);
            PG8_WAIT_V(8); PG8_WAIT_L(0); PG8_BAR; PG8_MMA(1, 0, At, B0); PG8_MMA(1, 1, At, B1); PG8_BAR; PG8_SCHED;
            PG8_LDB(B0, 1, 0); PG8_LDB(B1, 1, 1); PG8_SCHED; PG8_LDA(At, 1, 0); PG8_STA(0, 1, a2);
            PG8_WAIT_V(8); PG8_WAIT_L(0); PG8_BAR; PG8_MMA(0, 0, At, B0); PG8_MMA(0, 1, At, B1); PG8_BAR; PG8_SCHED;
            PG8_LDA(At, 1, 1); PG8_STAGE(PG8_SB(1, 0), b3, voffB); PG8_STAGE(PG8_SB(1, 1), b3 + hstepB, voffB); PG8_STA(1, 0, a3);
            PG8_WAIT_V(8); PG8_WAIT_L(0); PG8_BAR; PG8_MMA(1, 0, At, B0); PG8_MMA(1, 1, At, B1); PG8_BAR; PG8_SCHED;
        }
        if (wr == 0) PG8_BAR;
        E(acc, cur, wr, wc, fr, fq);
        if (!has_next) break;
#pragma unroll
        for (int a = 0; a < 2; ++a)
#pragma unroll
            for (int b = 0; b < 2; ++b)
#pragma unroll
                for (int m = 0; m < 4; ++m)
#pragma unroll
                    for (int n = 0; n < 2; ++n) acc[a][b][m][n] = (f32x4){0.f, 0.f, 0.f, 0.f};
        cur = nxt; cA = nA; cB = nB; ++ui;
        if (wr == 1) PG8_BAR;
    }
    PG8_WAIT_V(0);
    PG8_BAR;
#undef PG8_SA
#undef PG8_SB
#undef PG8_STAGE
#undef PG8_STA
#undef PG8_LOADG
#undef PG8_LDA
#undef PG8_LDB
#undef PG8_MMA
#undef PG8_WAIT_V
#undef PG8_WAIT_L
#undef PG8_BAR
#undef PG8_SCHED
}
}

constexpr int NWAVES = 8;
constexpr int M_TOK = 16384, D = 2048, SEQ = 4096, NB_ = 4;
constexpr int NPROJ = 2304, DATT = 1024, DSSM = 1024;
constexpr int NEXP = 32, DFF = 512, NRT = 48;
constexpr int MAXTILES = 160, MAXSLOTS = MAXTILES * 256;
constexpr float EPS = 1e-6f;
constexpr float LOG2E = 1.4426950408889634f;

constexpr size_t MiB = 1u << 20;
constexpr size_t WS_CTL = 0, CTL_ZERO_BYTES = 1 * MiB;
constexpr size_t WS_SMALL = 1 * MiB;
constexpr size_t SM_A16 = 0, SM_ONES = 32 * 1024, SM_GCAT = 40 * 1024, SM_WRH = 64 * 1024, SM_WRL = SM_WRH + (size_t)NRT * D * 2;
constexpr size_t WS_WIN = 2 * MiB, WS_WGLU = 11 * MiB, WS_WOUT = 13 * MiB, WS_TE = 21 * MiB, WS_WP = 33 * MiB, WS_WGU = 41 * MiB, WS_WD = 169 * MiB;
constexpr size_t WS_XN = 233 * MiB, WS_Q = 297 * MiB, WS_KV = 329 * MiB, WS_UX = 337 * MiB;
constexpr size_t WS_S = 233 * MiB, WS_ATT = 265 * MiB;
constexpr size_t WS_RSA = 385 * MiB, WS_RSS = 386 * MiB;
constexpr size_t WS_YG = 387 * MiB, WS_SG = 419 * MiB, WS_MIX = 451 * MiB;
constexpr size_t WS_TB = 233 * MiB, WS_HID = 457 * MiB, WS_O = 297 * MiB, WS_ROUTE = 497 * MiB;
constexpr size_t RT_REC = 0, RT_ETOK = 1 * MiB, RT_EW = 3 * MiB, RT_ERS = 5 * MiB;
constexpr size_t WS_END = 515 * MiB;
static_assert(WS_O + (size_t)MAXSLOTS * D * 2 <= WS_HID && WS_HID + (size_t)MAXSLOTS * DFF * 2 <= WS_ROUTE && WS_ROUTE + 7 * MiB <= WS_END, "d_ws map");
constexpr int CW_TMO = 0, CW_CODE = 1;
constexpr int CW_BAR = 4096;
constexpr int CW_CNT = 16384;
constexpr int CW_Q0 = 32768, CW_Q1 = 33024;

constexpr int RING_OFF = 0, RING_BYTES = 131072;
constexpr int LDSCTL_OFF = RING_BYTES, MISC_OFF = LDSCTL_OFF + 320, TB_OFF = LDSCTL_OFF + 1024;
constexpr int SC_OFF = LDSCTL_OFF + 10240;
constexpr int GIDX_OFF = LDSCTL_OFF + 2048;
constexpr int LDS_BYTES = 147456;

#define GAS __attribute__((address_space(1)))
#define LAS __attribute__((address_space(3)))
typedef unsigned short bf16;
typedef unsigned v4u __attribute__((ext_vector_type(4)));
typedef unsigned v2u __attribute__((ext_vector_type(2)));
typedef float f32x4 __attribute__((ext_vector_type(4)));
typedef float f32x16 __attribute__((ext_vector_type(16)));
typedef short bf16x8 __attribute__((ext_vector_type(8)));
typedef GAS unsigned gu32;
#define RLX_AGENT __ATOMIC_RELAXED, __HIP_MEMORY_SCOPE_AGENT
#define LDS_WAIT() asm volatile("s_waitcnt lgkmcnt(0)" ::: "memory")
#define VM_WAIT() asm volatile("s_waitcnt vmcnt(0)" ::: "memory")
__device__ __forceinline__ unsigned f2bf(float f) { unsigned u = __builtin_bit_cast(unsigned, f); return (u + 0x7fffu + ((u >> 16) & 1u)) >> 16; }
__device__ __forceinline__ unsigned pk2(float lo, float hi) { return f2bf(lo) | (f2bf(hi) << 16); }
__device__ __forceinline__ float bf2f(unsigned h) { return __uint_as_float(h << 16); }

#define XB_TMO      128
#define XB_XCNT(j)  (256  + 64 * (j))
#define XB_XSUB(j)  (1280 + 64 * (j))
#define XB_XGEN(j)  (2304 + 64 * (j))
#define XB_TOP      3328
#define XB_TOPGEN   3392
#define XCD_BAR_WORDS 3456
#define XB_SPIN_CAP (1u << 18)

__device__ __forceinline__ unsigned xb_ld(unsigned* p)              { return __hip_atomic_load(p, __ATOMIC_RELAXED, __HIP_MEMORY_SCOPE_AGENT); }
__device__ __forceinline__ unsigned xb_add(unsigned* p, unsigned v) { return __hip_atomic_fetch_add(p, v, __ATOMIC_RELAXED, __HIP_MEMORY_SCOPE_AGENT); }
__device__ __forceinline__ unsigned xb_xcc_id() { return (unsigned)__builtin_amdgcn_s_getreg((3 << 11) | 20) & 0xFu; }
#define XB_SPIN(cond, bar) do { unsigned _sp = 0; while (cond) { __builtin_amdgcn_s_sleep(1); \
    if ((++_sp & 255u) == 0u) { if (xb_ld(&(bar)[XB_TMO])) break; if (_sp > XB_SPIN_CAP) { atomicAdd(&(bar)[XB_TMO], 1u); break; } } } } while (0)

struct XcdBarrier {
    unsigned* bar; unsigned x;
    volatile LAS unsigned* st;
};

__device__ __forceinline__ XcdBarrier xcd_barrier_post(unsigned* bar, volatile LAS unsigned* st, bool thread0) {
    XcdBarrier b; b.bar = bar; b.x = xb_xcc_id(); b.st = st;
    if (thread0) (void)xb_add(&bar[XB_XCNT(b.x)], 1u);
    return b;
}
__device__ __forceinline__ void xcd_barrier_complete(unsigned* bar, unsigned x, unsigned& nloc, unsigned& nx) {
    const unsigned G = gridDim.x * gridDim.y * gridDim.z;
    unsigned sum, cnt, mine, sp = 0u;
    for (;;) {
        sum = 0u; cnt = 0u; mine = 0u;
#pragma unroll
        for (unsigned j = 0; j < 16; ++j) { const unsigned c = xb_ld(&bar[XB_XCNT(j)]); sum += c; cnt += (c > 0u) ? 1u : 0u; mine = (j == x) ? c : mine; }
        if (sum == G) break;
        __builtin_amdgcn_s_sleep(1);
        if ((++sp & 255u) == 0u) { if (xb_ld(&bar[XB_TMO])) break; if (sp > XB_SPIN_CAP) { atomicAdd(&bar[XB_TMO], 1u); break; } }
    }
    nloc = mine > 0u ? mine : 1u; nx = cnt > 0u ? cnt : 1u;
}

__device__ __forceinline__ void xcd_barrier(const XcdBarrier& b, bool thread0) {
    asm volatile("s_waitcnt vmcnt(0)" ::: "memory");
    __syncthreads();
    if (thread0) {
        unsigned* bar = b.bar;
        __builtin_amdgcn_s_waitcnt(0);
        unsigned nloc = b.st[0], nx = b.st[1];
        if (nloc == 0u) { xcd_barrier_complete(bar, b.x, nloc, nx); b.st[0] = nloc; b.st[1] = nx; }
        const unsigned old = xb_add(&bar[XB_XSUB(b.x)], 1u);
        const unsigned gen = old / nloc;
        if (old + 1u == (gen + 1u) * nloc) {
            __builtin_amdgcn_fence(__ATOMIC_RELEASE, "agent");
            asm volatile("s_waitcnt vmcnt(0)" ::: "memory");
            const unsigned og = xb_add(&bar[XB_TOP], 1u);
            const unsigned tg = og / nx;
            if (og + 1u == (tg + 1u) * nx) xb_add(&bar[XB_TOPGEN], 1u);
            else XB_SPIN(xb_ld(&bar[XB_TOPGEN]) == tg, bar);
            __builtin_amdgcn_fence(__ATOMIC_ACQUIRE, "agent");
            xb_add(&bar[XB_XGEN(b.x)], 1u);
            asm volatile("s_waitcnt vmcnt(0)" ::: "memory");
        } else {
            XB_SPIN(xb_ld(&bar[XB_XGEN(b.x)]) == gen, bar);
            __builtin_amdgcn_fence(__ATOMIC_ACQUIRE, "agent");
            asm volatile("s_waitcnt vmcnt(0)" ::: "memory");
        }
    }
    __syncthreads();
}

struct Frame {
    LAS unsigned char* lds;
    volatile LAS unsigned* MISC;
    gu32* ctl;
    int wave;
    int vcu, G;
};
__device__ __forceinline__ float wave_sum(float v) {
#pragma unroll
    for (int o = 1; o < 64; o <<= 1) v += __shfl_xor(v, o);
    return v;
}
__device__ __forceinline__ float dot4(f32x4 a) { return (a.x * a.x + a.y * a.y) + (a.z * a.z + a.w * a.w); }

__device__ __forceinline__ void p0_transpose_item(const float* W, int N, bf16* WT, int ldk, size_t drow0, int k0, int n0, const float* kscale, LAS float* scr, int lane) {
#pragma unroll 8
    for (int i = 0; i < 32; ++i) { const int kk = 2 * i + (lane >> 5); scr[kk * 33 + (lane & 31)] = W[(size_t)(k0 + kk) * N + n0 + (lane & 31)]; }
    LDS_WAIT(); asm volatile("" ::: "memory");
    const int c = lane & 7;
    float sc[8];
#pragma unroll
    for (int j = 0; j < 8; ++j) sc[j] = kscale ? kscale[k0 + 8 * c + j] : 1.f;
#pragma unroll
    for (int j = 0; j < 4; ++j) { const int n = (lane >> 3) + 8 * j; const LAS float* s = scr + (8 * c) * 33 + n;
        v4u o; o.x = pk2(s[0 * 33] * sc[0], s[1 * 33] * sc[1]); o.y = pk2(s[2 * 33] * sc[2], s[3 * 33] * sc[3]); o.z = pk2(s[4 * 33] * sc[4], s[5 * 33] * sc[5]); o.w = pk2(s[6 * 33] * sc[6], s[7 * 33] * sc[7]);
        *(GAS v4u*)(WT + (drow0 + n) * (size_t)ldk + k0 + 8 * c) = o; }
    LDS_WAIT(); asm volatile("" ::: "memory");
}
struct TItem { const float* W; bf16* WT; const float* ks; int N, ldk, k0, n0; size_t drow0; };
template <bool SCALED, bool NT> __device__ __forceinline__ void titem_load(f32x4 (&rg)[8], f32x4 (&sc)[2], const TItem& t, int lane) {
    if constexpr (SCALED) { sc[0] = *(const GAS f32x4*)(t.ks + t.k0 + 8 * (lane & 7)); sc[1] = *(const GAS f32x4*)(t.ks + t.k0 + 8 * (lane & 7) + 4); } else { sc[0] = (f32x4){1.f, 1.f, 1.f, 1.f}; sc[1] = sc[0]; }
    const float* p = t.W + (size_t)(t.k0 + (lane >> 3)) * t.N + t.n0 + 4 * (lane & 7);
#pragma unroll
    for (int i = 0; i < 8; ++i) { if constexpr (NT) rg[i] = __builtin_nontemporal_load((const GAS f32x4*)(p + (size_t)(8 * i) * t.N)); else rg[i] = *(const GAS f32x4*)(p + (size_t)(8 * i) * t.N); }
}
template <bool NT> __device__ __forceinline__ void titem_finish(const f32x4 (&rg)[8], const f32x4 (&sc)[2], const TItem& t, LAS float* scr, int lane) {
#pragma unroll
    for (int i = 0; i < 8; ++i) { LAS float* d = scr + (8 * i + (lane >> 3)) * 33 + 4 * (lane & 7); d[0] = rg[i].x; d[1] = rg[i].y; d[2] = rg[i].z; d[3] = rg[i].w; }
    LDS_WAIT(); asm volatile("" ::: "memory");
    const int c = lane & 7;
#pragma unroll
    for (int j = 0; j < 4; ++j) { const int n = (lane >> 3) + 8 * j; const LAS float* s = scr + (8 * c) * 33 + n;
        v4u o; o.x = pk2(s[0 * 33] * sc[0].x, s[1 * 33] * sc[0].y); o.y = pk2(s[2 * 33] * sc[0].z, s[3 * 33] * sc[0].w); o.z = pk2(s[4 * 33] * sc[1].x, s[5 * 33] * sc[1].y); o.w = pk2(s[6 * 33] * sc[1].z, s[7 * 33] * sc[1].w);
        if constexpr (NT) __builtin_nontemporal_store(o, (GAS v4u*)(t.WT + (t.drow0 + n) * (size_t)t.ldk + t.k0 + 8 * c)); else *(GAS v4u*)(t.WT + (t.drow0 + n) * (size_t)t.ldk + t.k0 + 8 * c) = o; }
    LDS_WAIT(); asm volatile("" ::: "memory");
}
constexpr int IT_WGLU = 16 * 32, IT_WOUT = 32 * 64, IT_GU = 32 * 32 * 16, IT_DN = 32 * 8 * 64, NQ1 = IT_WGLU + IT_WOUT + 2 * IT_GU + IT_DN;
__device__ __forceinline__ TItem decode_q1(int r, const float* ones, const float* gcat, const float* w_glu, const float* w_out, const float* g_ffn, const float* w_gate, const float* w_up, const float* w_down, unsigned char* ws) {
    TItem t;
    if (r < IT_WGLU) { const int kb = r / 32, nb = r - kb * 32; t.W = w_glu; t.N = DSSM; t.WT = (bf16*)(ws + WS_WGLU); t.ldk = DSSM; t.drow0 = (size_t)32 * nb; t.k0 = 64 * kb; t.n0 = 32 * nb; t.ks = ones; return t; } r -= IT_WGLU;
    if (r < IT_WOUT) { const int kb = r / 64, nb = r - kb * 64; t.W = w_out; t.N = D; t.WT = (bf16*)(ws + WS_WOUT); t.ldk = D; t.drow0 = (size_t)32 * nb; t.k0 = 64 * kb; t.n0 = 32 * nb; t.ks = gcat; return t; } r -= IT_WOUT;
    if (r < 2 * IT_GU) { const int up = r >= IT_GU ? 1 : 0; const int r2 = r - up * IT_GU, E = r2 >> 9, q2 = r2 & 511, kb = q2 >> 4, nb = q2 & 15, f0 = 32 * nb;
        t.W = (up ? w_up : w_gate) + (size_t)E * D * DFF; t.N = DFF; t.WT = (bf16*)(ws + WS_WGU); t.ldk = D; t.drow0 = (size_t)E * 1024 + (f0 >> 7) * 256 + up * 128 + (f0 & 127); t.k0 = 64 * kb; t.n0 = f0; t.ks = g_ffn; return t; } r -= 2 * IT_GU;
    { const int E = r >> 9, q2 = r & 511, kb = q2 >> 6, nb = q2 & 63; t.W = w_down + (size_t)E * DFF * D; t.N = D; t.WT = (bf16*)(ws + WS_WD); t.ldk = DFF; t.drow0 = (size_t)E * D + 32 * nb; t.k0 = 64 * kb; t.n0 = 32 * nb; t.ks = ones; return t; }
}
__device__ __forceinline__ void rms_row_to_bf16(const float* xrow, const float* g, bf16* orow, int lane) {
    const GAS f32x4* xr = (const GAS f32x4*)xrow + lane;
    f32x4 v[8]; float s = 0.f;
#pragma unroll
    for (int j = 0; j < 8; ++j) { v[j] = xr[64 * j]; s += dot4(v[j]); }
    const float rstd = 1.f / sqrtf(wave_sum(s) * (1.f / D) + EPS);
    GAS unsigned long long* o8 = (GAS unsigned long long*)orow + lane;
#pragma unroll
    for (int j = 0; j < 8; ++j) { const f32x4 gv = ((const GAS f32x4*)g)[lane + 64 * j];
        o8[64 * j] = (unsigned long long)pk2(v[j].x * rstd * gv.x, v[j].y * rstd * gv.y) | ((unsigned long long)pk2(v[j].z * rstd * gv.z, v[j].w * rstd * gv.w) << 32); }
}
__device__ __forceinline__ double exp_d(double x) {
    const double kf = __builtin_rint(x * 1.4426950408889634074); const double r = x - kf * 0.6931471805599453094;
    double p = 1.0;
#pragma unroll
    for (int i = 18; i >= 1; --i) p = 1.0 + r * p * (1.0 / (double)i);
    return __builtin_ldexp(p, (int)kf);
}
__device__ __forceinline__ void sincos_d(double th, double& sn, double& cs) {
    const double k = __builtin_rint(th * 0.15915494309189533577); const double r = th - k * 6.283185307179586477; const double r2 = r * r;
    double s = 1.0, c = 1.0;
#pragma unroll
    for (int i = 15; i >= 1; --i) { s = 1.0 - r2 * s * (1.0 / (double)((2 * i) * (2 * i + 1))); c = 1.0 - r2 * c * (1.0 / (double)((2 * i - 1) * (2 * i))); }
    sn = r * s; cs = c;
}
__device__ __forceinline__ void p0_ssm_tables(Frame& F, int g, const float* lam_re, const float* lam_im, const float* log_dt, const float* b_re, const float* b_im,
                                              const float* c_re, const float* c_im, const float* d_skip, bf16* TE, bf16* WP, float* A16) {
    LAS float* Apr = (LAS float*)(F.lds);
    LAS float* Api = Apr + 17 * 64;
    LAS float* Bbr = Api + 17 * 64;
    LAS float* Bbi = Bbr + 1024;
    LAS float* Cr = Bbi + 1024;
    LAS float* Ci = Cr + 1024;
    LAS float* Dk = Ci + 1024;
    LAS float* Kt = Dk + 16;
    int tid = F.wave * 64 + pg8::lane_id_(); asm volatile("" : "+v"(tid));
    if (tid < 64) { const int p = tid;
        const double dt = exp_d((double)log_dt[g]); const double lr = (double)lam_re[g * 64 + p], li = (double)lam_im[g * 64 + p];
        const double mag = exp_d(lr * dt); double sn, cs; sincos_d(li * dt, sn, cs);
        const double ar = mag * cs, ai = mag * sn, den = lr * lr + li * li;
        const double cr = ((ar - 1.0) * lr + ai * li) / den, ci = (ai * lr - (ar - 1.0) * li) / den;
        double pr = 1.0, pi = 0.0;
        for (int t = 0; t < 17; ++t) { Apr[t * 64 + p] = (float)pr; Api[t * 64 + p] = (float)pi; const double nr = pr * ar - pi * ai, ni = pr * ai + pi * ar; pr = nr; pi = ni; }
        A16[(g * 64 + p) * 2 + 0] = Apr[16 * 64 + p]; A16[(g * 64 + p) * 2 + 1] = Api[16 * 64 + p];
        for (int hh = 0; hh < 16; ++hh) { const double br = (double)b_re[(g * 64 + p) * 16 + hh], bi = (double)b_im[(g * 64 + p) * 16 + hh];
            Bbr[p * 16 + hh] = (float)(cr * br - ci * bi); Bbi[p * 16 + hh] = (float)(cr * bi + ci * br); }
    }
    for (int i = tid; i < 1024; i += 512) { Cr[i] = c_re[g * 1024 + i]; Ci[i] = c_im[g * 1024 + i]; }
    if (tid < 16) Dk[tid] = d_skip[g * 16 + tid];
    __syncthreads();
    for (int i = 0; i < 8; ++i) { const int idx = tid + 512 * i, tau = idx >> 8, ho = (idx >> 4) & 15, hi = idx & 15; float acc = 0.f;
        for (int p = 0; p < 64; ++p) { const float a_r = Apr[tau * 64 + p], a_i = Api[tau * 64 + p], b_r = Bbr[p * 16 + hi], b_i = Bbi[p * 16 + hi];
            const float abr = a_r * b_r - a_i * b_i, abi = a_r * b_i + a_i * b_r; acc += Cr[ho * 64 + p] * abr - Ci[ho * 64 + p] * abi; }
        Kt[idx] = acc; }
    __syncthreads();
    for (int i = 0; i < 24; ++i) { const int v = tid + 512 * i, n = v / 48, kv = v - n * 48, tau = n >> 4, ho = n & 15; float val[8];
        if (kv < 32) { const int s = kv >> 1, hi0 = (kv & 1) * 8;
#pragma unroll
            for (int j = 0; j < 8; ++j) { float x = (s <= tau) ? Kt[(tau - s) * 256 + ho * 16 + hi0 + j] : 0.f; if (s == tau && hi0 + j == ho) x += Dk[ho]; val[j] = x; }
        } else {
#pragma unroll
            for (int j = 0; j < 8; ++j) { const int pe = (kv - 32) * 8 + j, p = pe & 63; const float a_r = Apr[(tau + 1) * 64 + p], a_i = Api[(tau + 1) * 64 + p], c_r = Cr[ho * 64 + p], c_i = Ci[ho * 64 + p];
                val[j] = (pe < 64) ? (c_r * a_r - c_i * a_i) : -(c_r * a_i + c_i * a_r); }
        }
        v4u o; o.x = pk2(val[0], val[1]); o.y = pk2(val[2], val[3]); o.z = pk2(val[4], val[5]); o.w = pk2(val[6], val[7]);
        *(GAS v4u*)(TE + ((size_t)(g * 256 + n)) * 384 + kv * 8) = o; }
    for (int i = 0; i < 16; ++i) { const int v = tid + 512 * i, n = v >> 5, kv = v & 31, s = kv >> 1, hi0 = (kv & 1) * 8; float val[8];
#pragma unroll
        for (int j = 0; j < 8; ++j) { float x = 0.f;
            if (n < 128) { const int p = n & 63; const float a_r = Apr[(15 - s) * 64 + p], a_i = Api[(15 - s) * 64 + p], b_r = Bbr[p * 16 + hi0 + j], b_i = Bbi[p * 16 + hi0 + j];
                x = (n < 64) ? (a_r * b_r - a_i * b_i) : (a_r * b_i + a_i * b_r); }
            val[j] = x; }
        v4u o; o.x = pk2(val[0], val[1]); o.y = pk2(val[2], val[3]); o.z = pk2(val[4], val[5]); o.w = pk2(val[6], val[7]);
        *(GAS v4u*)(WP + ((size_t)(g * 256 + n)) * 256 + kv * 8) = o; }
    __syncthreads();
}

__device__ const unsigned char T5_BUCKET[128] = {0, 1, 2, 3, 4, 5, 6, 7, 8, 9, 10, 11, 12, 13, 14, 15, 16, 16, 16, 17, 17, 18, 18, 18, 19, 19, 19, 20, 20, 20, 20, 21, 21, 21, 21, 22, 22, 22, 22, 22, 23, 23, 23, 23, 23, 23, 24, 24, 24, 24, 24, 24,
    25, 25, 25, 25, 25, 25, 25, 26, 26, 26, 26, 26, 26, 26, 26, 27, 27, 27, 27, 27, 27, 27, 27, 27, 27, 28, 28, 28, 28, 28, 28, 28, 28, 28, 28, 29, 29, 29, 29, 29, 29, 29, 29, 29, 29, 29, 29, 30, 30, 30, 30, 30, 30, 30, 30, 30, 30, 30, 30, 30, 30,
    31, 31, 31, 31, 31, 31, 31, 31, 31, 31, 31, 31, 31, 31, 31};
constexpr int AT_KS = 0, AT_KSTRIDE = 144, AT_VT = 256 * 144, AT_VSTRIDE = 528, AT_BT = AT_VT + 64 * 528;
constexpr float NEGBIG = -1e30f;
__device__ __forceinline__ void attn_unit(LAS unsigned char* lds, int b, int nb, int kvh, const bf16* Qb, const bf16* KV, const float* btab, const float* sinks, bf16* ATT, float* RSA, int tid, int lane, int wave) {
    const int head = kvh * 8 + wave;
    for (int i = tid; i < 8 * 192; i += 512) { const int w = i / 192, n = (i - w * 192) - 32; float v = NEGBIG; if (n >= 0 && n < 128) v = btab[(int)T5_BUCKET[n] * 16 + kvh * 8 + w] * LOG2E; ((LAS float*)(lds + AT_BT))[i] = v; }
    const long tok0 = (long)b * SEQ + (long)nb * 128 - 128;
#pragma unroll
    for (int i = 0; i < 4; ++i) { const int idx = tid + 512 * i, row = idx >> 3, ch = idx & 7;
        if (nb > 0 || row >= 128) {
            const bf16* src = KV + (tok0 + row) * 256 + kvh * 64 + ch * 8;
            const v4u kv = *(const GAS v4u*)src; const v4u vv = *(const GAS v4u*)(src + 128);
            *(LAS v4u*)(lds + AT_KS + row * AT_KSTRIDE + ch * 16) = kv;
            const int pos = (row & ~12) | ((row & 4) << 1) | ((row & 8) >> 1);
            LAS bf16* vt = (LAS bf16*)(lds + AT_VT) + (ch * 8) * 264 + pos;
            vt[0 * 264] = (bf16)(vv.x & 0xffffu); vt[1 * 264] = (bf16)(vv.x >> 16); vt[2 * 264] = (bf16)(vv.y & 0xffffu); vt[3 * 264] = (bf16)(vv.y >> 16);
            vt[4 * 264] = (bf16)(vv.z & 0xffffu); vt[5 * 264] = (bf16)(vv.z >> 16); vt[6 * 264] = (bf16)(vv.w & 0xffffu); vt[7 * 264] = (bf16)(vv.w >> 16);
        } }
    __syncthreads();
    const int r = lane & 31, h = lane >> 5;
    const float sinkL2 = sinks[head] * LOG2E;
    const LAS float* bt = (const LAS float*)(lds + AT_BT) + wave * 192 + 32 + (r - 4 * h);
    for (int j = 0; j < 4; ++j) {
        const long qrow = (long)b * SEQ + nb * 128 + 32 * j + r;
        bf16x8 qf[4];
#pragma unroll
        for (int ds = 0; ds < 4; ++ds) qf[ds] = *(const GAS bf16x8*)(Qb + qrow * 1024 + head * 64 + 16 * ds + 8 * h);
        f32x16 S[5];
#pragma unroll
        for (int c = 0; c < 5; ++c) { const int kt = j + c; const bool valid = (nb > 0) || (kt >= 4);
            f32x16 a;
#pragma unroll
            for (int reg = 0; reg < 16; ++reg) a[reg] = 0.f;
            if (valid) {
#pragma unroll
                for (int ds = 0; ds < 4; ++ds) { const bf16x8 kf = *(const LAS bf16x8*)(lds + AT_KS + (32 * kt + r) * AT_KSTRIDE + (16 * ds + 8 * h) * 2); a = __builtin_amdgcn_mfma_f32_32x32x16_bf16(kf, qf[ds], a, 0, 0, 0); }
#pragma unroll
                for (int reg = 0; reg < 16; ++reg) a[reg] += bt[128 - 32 * c - ((reg & 3) + 8 * (reg >> 2))];
            } else {
#pragma unroll
                for (int reg = 0; reg < 16; ++reg) a[reg] = NEGBIG;
            }
            S[c] = a; }
        float mx = sinkL2;
#pragma unroll
        for (int c = 0; c < 5; ++c)
#pragma unroll
            for (int reg = 0; reg < 16; ++reg) mx = fmaxf(mx, S[c][reg]);
        mx = fmaxf(mx, __shfl_xor(mx, 32));
        float l = 0.f;
#pragma unroll
        for (int c = 0; c < 5; ++c)
#pragma unroll
            for (int reg = 0; reg < 16; ++reg) { const float p = __builtin_amdgcn_exp2f(S[c][reg] - mx); S[c][reg] = p; l += p; }
        l += __shfl_xor(l, 32); l += __builtin_amdgcn_exp2f(sinkL2 - mx);
        f32x16 o0, o1;
#pragma unroll
        for (int reg = 0; reg < 16; ++reg) { o0[reg] = 0.f; o1[reg] = 0.f; }
#pragma unroll
        for (int c = 0; c < 5; ++c) { const int kt = j + c; const bool valid = (nb > 0) || (kt >= 4);
            if (valid) {
#pragma unroll
                for (int s2 = 0; s2 < 2; ++s2) { v4u pw; pw.x = pg8::cvt_pk_bf16(S[c][8 * s2 + 0], S[c][8 * s2 + 1]); pw.y = pg8::cvt_pk_bf16(S[c][8 * s2 + 2], S[c][8 * s2 + 3]);
                    pw.z = pg8::cvt_pk_bf16(S[c][8 * s2 + 4], S[c][8 * s2 + 5]); pw.w = pg8::cvt_pk_bf16(S[c][8 * s2 + 6], S[c][8 * s2 + 7]);
                    const bf16x8 pf = __builtin_bit_cast(bf16x8, pw);
                    const bf16x8 v0 = *(const LAS bf16x8*)(lds + AT_VT + r * AT_VSTRIDE + (32 * kt + 16 * s2 + 8 * h) * 2);
                    const bf16x8 v1 = *(const LAS bf16x8*)(lds + AT_VT + (32 + r) * AT_VSTRIDE + (32 * kt + 16 * s2 + 8 * h) * 2);
                    o0 = __builtin_amdgcn_mfma_f32_32x32x16_bf16(v0, pf, o0, 0, 0, 0); o1 = __builtin_amdgcn_mfma_f32_32x32x16_bf16(v1, pf, o1, 0, 0, 0); }
            } }
        const float inv = 1.0f / l; float ss = 0.f;
        bf16* orow = ATT + qrow * 2048 + head * 64 + 4 * h;
#pragma unroll
        for (int g4 = 0; g4 < 4; ++g4) { const float a0 = o0[4 * g4] * inv, a1 = o0[4 * g4 + 1] * inv, a2 = o0[4 * g4 + 2] * inv, a3 = o0[4 * g4 + 3] * inv;
            const float c0 = o1[4 * g4] * inv, c1 = o1[4 * g4 + 1] * inv, c2 = o1[4 * g4 + 2] * inv, c3 = o1[4 * g4 + 3] * inv;
            ss += (a0 * a0 + a1 * a1) + (a2 * a2 + a3 * a3) + (c0 * c0 + c1 * c1) + (c2 * c2 + c3 * c3);
            v2u w0; w0.x = pg8::cvt_pk_bf16(a0, a1); w0.y = pg8::cvt_pk_bf16(a2, a3); v2u w1; w1.x = pg8::cvt_pk_bf16(c0, c1); w1.y = pg8::cvt_pk_bf16(c2, c3);
            *(GAS v2u*)(orow + 8 * g4) = w0; *(GAS v2u*)(orow + 32 + 8 * g4) = w1; }
        ss += __shfl_xor(ss, 32);
        if (h == 0) RSA[qrow * 16 + head] = ss;
    }
    __syncthreads();
}


__device__ __forceinline__ void ssm_carry(LAS unsigned char* lds, int L, const float* A16, const float* Sst, bf16* UX, int wave, int lane) {
    const int g = L >> 2, p = lane;
    const float a_r = A16[(g * 64 + p) * 2], a_i = A16[(g * 64 + p) * 2 + 1];
    const float* Sp = Sst + ((size_t)L * 256 + wave * 32) * 128 + p;
    float sr[32], si[32];
#pragma unroll
    for (int c = 0; c < 32; ++c) { sr[c] = Sp[(size_t)c * 128]; si[c] = Sp[(size_t)c * 128 + 64]; }
    float xr = 0.f, xi = 0.f;
#pragma unroll
    for (int c = 0; c < 32; ++c) { const float nr = a_r * xr - a_i * xi + sr[c], ni = a_r * xi + a_i * xr + si[c]; xr = nr; xi = ni; }
    LAS float* se = (LAS float*)lds;
    se[(wave * 64 + p) * 2] = xr; se[(wave * 64 + p) * 2 + 1] = xi;
    float br = a_r, bi = a_i;
#pragma unroll
    for (int k = 0; k < 5; ++k) { const float t = br * br - bi * bi; bi = 2.f * br * bi; br = t; }
    __syncthreads();
    float cr = 0.f, ci = 0.f;
    for (int v = 0; v < 7; ++v) if (v < wave) { const float er = se[(v * 64 + p) * 2], ei = se[(v * 64 + p) * 2 + 1]; const float nr = br * cr - bi * ci + er, ni = br * ci + bi * cr + ei; cr = nr; ci = ni; }
    bf16* Xp = UX + ((size_t)L * 256 + wave * 32) * 384 + 256 + p;
    xr = cr; xi = ci;
#pragma unroll
    for (int c = 0; c < 32; ++c) { Xp[(size_t)c * 384] = (bf16)f2bf(xr); Xp[(size_t)c * 384 + 64] = (bf16)f2bf(xi);
        const float nr = a_r * xr - a_i * xi + sr[c], ni = a_r * xi + a_i * xr + si[c]; xr = nr; xi = ni; }
}

constexpr int RT_ROWB = 528, RT_BUF = 96 * RT_ROWB, RT_LG = 2 * RT_BUF;
__device__ __forceinline__ void route_phase(LAS unsigned char* lds, int R0, const bf16* TB, const bf16* WrH, const bf16* WrL, const float* brg, const float* bre, gu32* ctl, unsigned* rec, unsigned* etok, float* ew, float* ers, int tid, int lane, int wave) {
    const int r = lane & 15, kq = lane >> 4;
    v4u st[6];
#define RT_LOAD(k0) do { _Pragma("unroll") for (int j = 0; j < 6; ++j) { const int q = tid + 512 * j, row96 = q >> 5, pc = q & 31; const bf16* src = (row96 < 48 ? WrH + (size_t)row96 * D : WrL + (size_t)(row96 - 48) * D) + (k0) + pc * 8; st[j] = *(const GAS v4u*)src; } } while (0)
#define RT_STORE(buf) do { _Pragma("unroll") for (int j = 0; j < 6; ++j) { const int q = tid + 512 * j, row96 = q >> 5, pc = q & 31; *(LAS v4u*)(lds + (buf) * RT_BUF + row96 * RT_ROWB + pc * 16) = st[j]; } } while (0)
    f32x4 acc[3];
#pragma unroll
    for (int cb = 0; cb < 3; ++cb) acc[cb] = (f32x4){0.f, 0.f, 0.f, 0.f};
    float ss = 0.f;
    const bf16* tp = TB + (size_t)(R0 + (wave & 3) * 16 + r) * D + kq * 8;
    v4u a_cur[8], a_nxt[8];
    RT_LOAD(0);
    if (wave < 4) {
#pragma unroll
        for (int ks = 0; ks < 8; ++ks) a_cur[ks] = *(const GAS v4u*)(tp + ks * 32);
    }
    RT_STORE(0);
    __syncthreads();
    for (int s = 0; s < 8; ++s) {
        if (s < 7) { RT_LOAD((s + 1) * 256);
            if (wave < 4) {
#pragma unroll
                for (int ks = 0; ks < 8; ++ks) a_nxt[ks] = *(const GAS v4u*)(tp + (s + 1) * 256 + ks * 32);
            } }
        if (wave < 4) { const LAS unsigned char* bb = lds + (s & 1) * RT_BUF + r * RT_ROWB + kq * 16;
#pragma unroll
            for (int ks = 0; ks < 8; ++ks) { const v4u aw = a_cur[ks]; const bf16x8 af = __builtin_bit_cast(bf16x8, aw);
                { const float e0 = pg8::bf_lo(aw.x), e1 = pg8::bf_hi(aw.x), e2 = pg8::bf_lo(aw.y), e3 = pg8::bf_hi(aw.y), e4 = pg8::bf_lo(aw.z), e5 = pg8::bf_hi(aw.z), e6 = pg8::bf_lo(aw.w), e7 = pg8::bf_hi(aw.w);
                  ss += (e0 * e0 + e1 * e1) + (e2 * e2 + e3 * e3) + (e4 * e4 + e5 * e5) + (e6 * e6 + e7 * e7); }
#pragma unroll
                for (int cb = 0; cb < 3; ++cb) { const bf16x8 bh = *(const LAS bf16x8*)(bb + (cb * 16) * RT_ROWB + ks * 64), bl = *(const LAS bf16x8*)(bb + (48 + cb * 16) * RT_ROWB + ks * 64);
                    acc[cb] = __builtin_amdgcn_mfma_f32_16x16x32_bf16(af, bh, acc[cb], 0, 0, 0); acc[cb] = __builtin_amdgcn_mfma_f32_16x16x32_bf16(af, bl, acc[cb], 0, 0, 0); } }
#pragma unroll
            for (int ks = 0; ks < 8; ++ks) a_cur[ks] = a_nxt[ks];
        }
        if (s < 7) RT_STORE((s + 1) & 1);
        __syncthreads();
    }
#undef RT_LOAD
#undef RT_STORE
    if (wave < 4) {
        ss += __shfl_xor(ss, 16); ss += __shfl_xor(ss, 32);
        LAS float* lg = (LAS float*)(lds + RT_LG) + wave * (16 * 48);
#pragma unroll
        for (int cb = 0; cb < 3; ++cb)
#pragma unroll
            for (int reg = 0; reg < 4; ++reg) lg[(kq * 4 + reg) * 48 + cb * 16 + r] = acc[cb][reg];
        LDS_WAIT(); asm volatile("" ::: "memory");
        if (lane < 16) { const int row = lane, token = R0 + wave * 16 + row; const float rstd = 1.f / sqrtf(ss * (1.f / D) + EPS); const LAS float* lr = lg + row * 48;
            float gl[4]; float gmax = -3.4e38f; int gi = 0;
#pragma unroll
            for (int j = 0; j < 4; ++j) { gl[j] = lr[j] * rstd + brg[j]; if (gl[j] > gmax) { gmax = gl[j]; gi = j; } }
            float gsum = 0.f;
#pragma unroll
            for (int j = 0; j < 4; ++j) gsum += __expf(gl[j] - gmax);
            const float gate = 1.f / gsum;
            float v0 = -3.4e38f, v1 = -3.4e38f; int i0 = 0, i1 = 0;
#pragma unroll
            for (int e = 0; e < 8; ++e) { const float v = lr[4 + gi * 8 + e] * rstd + bre[gi * 8 + e];
                if (v > v0) { v1 = v0; i1 = i0; v0 = v; i0 = e; } else if (v > v1) { v1 = v; i1 = e; } }
            const float w0 = gate / (1.f + __expf(v1 - v0)), w1 = gate - w0;
            const int E0 = gi * 8 + i0, E1 = gi * 8 + i1;
            const unsigned p0 = __hip_atomic_fetch_add(ctl + CW_CNT + 64 * E0, 1u, RLX_AGENT), p1 = __hip_atomic_fetch_add(ctl + CW_CNT + 64 * E1, 1u, RLX_AGENT);
            v4u a; a.x = (unsigned)E0; a.y = p0; a.z = (unsigned)E1; a.w = p1; *(GAS v4u*)(rec + (size_t)token * 4) = a;
            const unsigned i0x = (unsigned)E0 * 16384u + p0, i1x = (unsigned)E1 * 16384u + p1;
            etok[i0x] = (unsigned)token; etok[i1x] = (unsigned)token; ew[i0x] = w0; ew[i1x] = w1; ers[i0x] = rstd; ers[i1x] = rstd;
        }
    }
    __syncthreads();
}

struct Args { const float* in[27]; float* out; unsigned char* ws; };
#ifndef DUP_MASK
#define DUP_MASK 0
#endif
typedef __attribute__((address_space(4))) const char* kargp_t;
__device__ __forceinline__ const void* karg(int k) { kargp_t p = (kargp_t)__builtin_amdgcn_kernarg_segment_ptr(); asm volatile("" : "+s"(p)); return *(const void* const __attribute__((address_space(4)))*)(p + 8 * k); }
#define KIN(k) ((const float*)karg(k))
#define KOUT() ((float*)karg(27))
#define KWS(T, off) ((T*)((unsigned char*)karg(28) + (off)))
#define IDS() int tid = F.wave * 64 + pg8::lane_id_(); asm volatile("" : "+v"(tid)); const int lane = tid & 63; (void)lane
__global__ void __launch_bounds__(NWAVES * 64, 2) hymba_fwd(Args args_unused) {
    extern __shared__ __attribute__((aligned(16))) unsigned char lds[];
    Frame F;
    F.lds = (LAS unsigned char*)lds;
    F.MISC = (volatile LAS unsigned*)(F.lds + MISC_OFF);
    F.wave = __builtin_amdgcn_readfirstlane((int)threadIdx.x >> 6);
    F.G = gridDim.x; { const int bx = blockIdx.x; F.vcu = (F.G % 8 == 0) ? (bx % 8) * (F.G / 8) + bx / 8 : bx; }
    F.ctl = (gu32*)KWS(unsigned char, WS_CTL);
    for (int u = threadIdx.x; u < (LDS_BYTES - LDSCTL_OFF) / 4; u += NWAVES * 64) ((LAS unsigned*)(F.lds + LDSCTL_OFF))[u] = 0u;
    __syncthreads();
    (void)xcd_barrier_post((unsigned*)(F.ctl + CW_BAR), F.MISC + 8, threadIdx.x == 0);
#define GRID_BAR() do { XcdBarrier b_; b_.bar = (unsigned*)KWS(unsigned, WS_CTL) + CW_BAR; b_.x = xb_xcc_id(); b_.st = F.MISC + 8; xcd_barrier(b_, F.wave == 0 && pg8::lane_id_() == 0); } while (0)
    const int gw = F.vcu * NWAVES + F.wave, NGW = F.G * NWAVES;
    LAS int* tbl = (LAS int*)(F.lds + TB_OFF);

#if (DUP_MASK >> 0) & 1
_Pragma("unroll") for (int rep_ = 0; rep_ < 2; ++rep_)
#else
    constexpr int rep_ = 0;
#endif
    {
        IDS();
        if (F.vcu < 64) p0_ssm_tables(F, F.vcu, KIN(5), KIN(6), KIN(7), KIN(8), KIN(9), KIN(10), KIN(11), KIN(12), KWS(bf16, WS_TE), KWS(bf16, WS_WP), KWS(float, WS_SMALL + SM_A16));
        { const float* g_ffn = KIN(18); const float* wrg = KIN(19); const float* wre = KIN(21); bf16* WrH = KWS(bf16, WS_SMALL + SM_WRH); bf16* WrL = KWS(bf16, WS_SMALL + SM_WRL);
          const int gtid = F.vcu * 512 + tid, NGT = F.G * 512;
          if (gtid < D) { KWS(float, WS_SMALL + SM_ONES)[gtid] = 1.0f; KWS(float, WS_SMALL + SM_GCAT)[gtid] = gtid < DATT ? KIN(15)[gtid] : KIN(16)[gtid - DATT]; }
          for (int e = gtid; e < NRT * D; e += NGT) { const int j = e / D, k = e - j * D; float w = 0.f;
            if (j < 4) w = wrg[k * 4 + j]; else if (j < 36) w = wre[((size_t)((j - 4) >> 3) * D + k) * 8 + ((j - 4) & 7)];
            w *= g_ffn[k]; const unsigned hi = f2bf(w); WrH[e] = (bf16)hi; WrL[e] = (bf16)f2bf(w - bf2f(hi)); } }
        { LAS float* scr = (LAS float*)(F.lds + RING_OFF + F.wave * 16384);
          constexpr int IT_WIN = 32 * 72, CH0 = 4, NQ0 = IT_WIN / CH0 + M_TOK / CH0;
          const float* w_in = KIN(3); const float* x = KIN(0); const float* g_mix = KIN(2); unsigned char* ws = KWS(unsigned char, 0);
          gu32* qh = F.ctl + CW_Q0 + 64 * rep_;
          unsigned qn = 0; if (lane == 0) qn = __hip_atomic_fetch_add(qh, 1u, RLX_AGENT);
          for (;;) { const int q = __builtin_amdgcn_readfirstlane((int)qn); if (q >= NQ0) break;
            if (lane == 0) qn = __hip_atomic_fetch_add(qh, 1u, RLX_AGENT);
            if (q < IT_WIN / CH0) { f32x4 rgA[8], rgB[8], scA[2], scB[2]; TItem tA, tB; tA.W = w_in; tA.N = NPROJ; tA.WT = (bf16*)(ws + WS_WIN); tA.ldk = D; tA.ks = nullptr; tB = tA;
#pragma unroll
                for (int i = 0; i < CH0; i += 2) { const int r0 = q * CH0 + i, r1 = r0 + 1; const int kb0 = r0 / 72, nb0 = r0 - kb0 * 72, kb1 = r1 / 72, nb1 = r1 - kb1 * 72;
                    tA.drow0 = (size_t)32 * nb0; tA.k0 = 64 * kb0; tA.n0 = 32 * nb0; tB.drow0 = (size_t)32 * nb1; tB.k0 = 64 * kb1; tB.n0 = 32 * nb1;
                    titem_load<false, false>(rgA, scA, tA, lane); titem_load<false, false>(rgB, scB, tB, lane); titem_finish<false>(rgA, scA, tA, scr, lane); titem_finish<false>(rgB, scB, tB, scr, lane); } }
            else { const int m = CH0 * (q - IT_WIN / CH0);
#pragma unroll
                for (int i = 0; i < CH0; ++i) rms_row_to_bf16(x + (size_t)(m + i) * D, g_mix, (bf16*)(ws + WS_XN) + (size_t)(m + i) * D, lane); } } }
        GRID_BAR();
    }
#if ((DUP_MASK >> 1) & 1) || ((DUP_MASK >> 4) & 1)
_Pragma("unroll") for (int rep1_ = 0; rep1_ < 2; ++rep1_)
#else
    constexpr int rep1_ = 0;
#endif
    {
        IDS();
        const bool gemm_cu = blockIdx.x < 192;
        if (gemm_cu && !(((DUP_MASK >> 4) & 1) && rep1_ == 1)) {
            unsigned char* ws = KWS(unsigned char, 0);
            pg8::StaticOrder S; S.init(M_TOK, NPROJ, 192, (int)blockIdx.x);
            pg8::EpiInProj E{(bf16*)(ws + WS_Q), (bf16*)(ws + WS_KV), (bf16*)(ws + WS_UX)};
            pg8::gemm_phase<pg8::EpiInProj, pg8::StaticOrder, D, D, D>(F.lds + RING_OFF, F.wave, (const bf16*)(ws + WS_XN), (const bf16*)(ws + WS_WIN), S, E);
        }
        if (!(((DUP_MASK >> 4) & 1) && rep1_ == 1 && gemm_cu))
        { LAS float* scr = (LAS float*)(F.lds + RING_OFF + F.wave * 16384);
          const float* w_glu = KIN(13); const float* w_out = KIN(17); const float* g_ffn = KIN(18); const float* w_gate = KIN(23); const float* w_up = KIN(24); const float* w_down = KIN(25);
          unsigned char* ws = KWS(unsigned char, 0); const float* ones = (const float*)(ws + WS_SMALL + SM_ONES); const float* gcat = (const float*)(ws + WS_SMALL + SM_GCAT);
          gu32* qh = F.ctl + CW_Q1 + 64 * rep1_;
          constexpr int CH = 8;
          static_assert(NQ1 % CH == 0, "chunks");
          unsigned qn = 0; if (lane == 0) qn = __hip_atomic_fetch_add(qh, 1u, RLX_AGENT);
          for (;;) { const int q0 = __builtin_amdgcn_readfirstlane((int)qn) * CH; if (q0 >= NQ1) break;
            if (lane == 0) qn = __hip_atomic_fetch_add(qh, 1u, RLX_AGENT);
            f32x4 rgA[8], rgB[8], scA[2], scB[2]; TItem tA = decode_q1(q0, ones, gcat, w_glu, w_out, g_ffn, w_gate, w_up, w_down, ws), tB; titem_load<true, true>(rgA, scA, tA, lane);
#pragma unroll
            for (int i = 0; i < CH; i += 2) { tB = decode_q1(q0 + i + 1, ones, gcat, w_glu, w_out, g_ffn, w_gate, w_up, w_down, ws); titem_load<true, true>(rgB, scB, tB, lane); titem_finish<true>(rgA, scA, tA, scr, lane);
                if (i + 2 < CH) { tA = decode_q1(q0 + i + 2, ones, gcat, w_glu, w_out, g_ffn, w_gate, w_up, w_down, ws); titem_load<true, true>(rgA, scA, tA, lane); } titem_finish<true>(rgB, scB, tB, scr, lane); } } }
        GRID_BAR();
    }
    {
        const int L = (int)blockIdx.x;
#if (DUP_MASK >> 2) & 1
_Pragma("unroll") for (int rep_ = 0; rep_ < 2; ++rep_)
#endif
        {
        { unsigned char* ws = KWS(unsigned char, 0); pg8::OneUnit S{L, L >> 2}; pg8::EpiS E{(float*)(ws + WS_S)};
          pg8::gemm_phase<pg8::EpiS, pg8::OneUnit, 256, 384, 256>(F.lds + RING_OFF, F.wave, (const bf16*)(ws + WS_UX), (const bf16*)(ws + WS_WP), S, E); }
        { int l2 = pg8::lane_id_(); asm volatile("" : "+v"(l2)); unsigned char* ws = KWS(unsigned char, 0); ssm_carry(F.lds + RING_OFF, L, (const float*)(ws + WS_SMALL + SM_A16), (const float*)(ws + WS_S), (bf16*)(ws + WS_UX), F.wave, l2); }
        VM_WAIT(); __syncthreads();
        { unsigned char* ws = KWS(unsigned char, 0); pg8::OneUnit S{L, L >> 2}; pg8::EpiY E{(bf16*)(ws + WS_YG)};
          pg8::gemm_phase<pg8::EpiY, pg8::OneUnit, 384, 384, 384>(F.lds + RING_OFF, F.wave, (const bf16*)(ws + WS_UX), (const bf16*)(ws + WS_TE), S, E); }
        }
#if (DUP_MASK >> 3) & 1
_Pragma("unroll") for (int rep_ = 0; rep_ < 2; ++rep_)
#endif
        { int t2 = F.wave * 64 + pg8::lane_id_(); asm volatile("" : "+v"(t2)); unsigned char* ws = KWS(unsigned char, 0); const float* rel_bias = KIN(1); const float* sinks = KIN(4);
          attn_unit(F.lds + RING_OFF, L >> 6, (L >> 1) & 31, L & 1, (const bf16*)(ws + WS_Q), (const bf16*)(ws + WS_KV), rel_bias, sinks, (bf16*)(ws + WS_MIX), (float*)(ws + WS_RSA), t2, t2 & 63, F.wave); }
        GRID_BAR();
    }
#if (DUP_MASK >> 5) & 1
_Pragma("unroll") for (int rep_ = 0; rep_ < 2; ++rep_)
#endif
    {
        IDS();
        unsigned char* ws = KWS(unsigned char, 0);
        pg8::StaticOrder S; S.init(M_TOK, DSSM, F.G, (int)blockIdx.x);
        pg8::EpiGLU E{(const bf16*)(ws + WS_YG), KIN(14), (bf16*)(ws + WS_MIX), (float*)(ws + WS_RSS)};
        pg8::gemm_phase<pg8::EpiGLU, pg8::StaticOrder, DSSM, DSSM, DSSM>(F.lds + RING_OFF, F.wave, (const bf16*)(ws + WS_YG), (const bf16*)(ws + WS_WGLU), S, E);
        GRID_BAR();
    }
#if (DUP_MASK >> 7) & 1
_Pragma("unroll") for (int rep_ = 0; rep_ < 2; ++rep_)
#endif
    {
        IDS();
        unsigned char* ws = KWS(unsigned char, 0);
        pg8::StaticOrder S; S.init(M_TOK, D, F.G, (int)blockIdx.x);
        LAS pg8::f32x2* sct = (LAS pg8::f32x2*)(F.lds + SC_OFF);
        { const float* RSA = (const float*)(ws + WS_RSA); const float* RSS = (const float*)(ws + WS_RSS);
          for (int j = 0; j < 2; ++j) { pg8::Unit u; if (!S.next(j, u)) break;
              if (tid < 256) { const int row = u.pm * 256 + tid; const GAS f32x4* pa = (const GAS f32x4*)(RSA + (size_t)row * 16); const GAS f32x4* ps = (const GAS f32x4*)(RSS + (size_t)row * 16);
                  const f32x4 a0 = pa[0], a1 = pa[1], a2 = pa[2], a3 = pa[3], s0 = ps[0], s1 = ps[1], s2 = ps[2], s3 = ps[3];
                  const float sa = ((a0.x + a0.y) + (a0.z + a0.w)) + ((a1.x + a1.y) + (a1.z + a1.w)) + ((a2.x + a2.y) + (a2.z + a2.w)) + ((a3.x + a3.y) + (a3.z + a3.w));
                  const float ss = ((s0.x + s0.y) + (s0.z + s0.w)) + ((s1.x + s1.y) + (s1.z + s1.w)) + ((s2.x + s2.y) + (s2.z + s2.w)) + ((s3.x + s3.y) + (s3.z + s3.w));
                  const float ra = 1.f / sqrtf(sa * (1.f / DATT) + EPS), rs = 1.f / sqrtf(ss * (1.f / DSSM) + EPS);
                  sct[j * 256 + tid] = (pg8::f32x2){ra / rs, rs}; } }
          __syncthreads(); }
        pg8::EpiXmid E{KIN(0), (bf16*)(ws + WS_TB), sct};
        pg8::gemm_phase<pg8::EpiXmid, pg8::StaticOrder, D, D, D>(F.lds + RING_OFF, F.wave, (const bf16*)(ws + WS_MIX), (const bf16*)(ws + WS_WOUT), S, E);
        GRID_BAR();
    }
#if (DUP_MASK >> 8) & 1
_Pragma("unroll") for (int rep8_ = 0; rep8_ < 2; ++rep8_)
#else
    constexpr int rep8_ = 1;
#endif
    {
        IDS();
        unsigned char* ws = KWS(unsigned char, 0); const float* brg = KIN(20); const float* bre = KIN(22);
        const size_t doff = rep8_ ? 0 : (WS_O - WS_ROUTE);
        for (int blk = blockIdx.x; blk < M_TOK / 64; blk += F.G) route_phase(F.lds + RING_OFF, blk * 64, (const bf16*)(ws + WS_TB), (const bf16*)(ws + WS_SMALL + SM_WRH), (const bf16*)(ws + WS_SMALL + SM_WRL), brg, bre, F.ctl + (rep8_ ? 0 : 4096),
            (unsigned*)(ws + WS_ROUTE + doff + RT_REC), (unsigned*)(ws + WS_ROUTE + doff + RT_ETOK), (float*)(ws + WS_ROUTE + doff + RT_EW), (float*)(ws + WS_ROUTE + doff + RT_ERS), tid, lane, F.wave);
        GRID_BAR();
    }
    {
        IDS();
        if (tid == 0) { int acc = 0; for (int e = 0; e < 32; ++e) { tbl[e] = acc; acc += (int)((__hip_atomic_load(F.ctl + CW_CNT + 64 * e, RLX_AGENT) + 255u) >> 8); } tbl[32] = acc; }
        __syncthreads();
        LAS int* gidx = (LAS int*)(F.lds + GIDX_OFF);
        { const unsigned* ETOK = KWS(unsigned, WS_ROUTE + RT_ETOK); pg8::MoeOrder S{tbl, 4, F.G, (int)blockIdx.x};
          for (int j = 0; j < 8; ++j) { pg8::Unit u; if (!S.next(j, u)) break; const int Ex = u.pn >> 2, mt = u.pm - tbl[Ex]; const int cntE = (int)__hip_atomic_load(F.ctl + CW_CNT + 64 * Ex, RLX_AGENT);
              if (tid < 256) { const int pos = mt * 256 + tid; gidx[j * 256 + tid] = pos < cntE ? (int)ETOK[(size_t)Ex * 16384 + pos] : 0; } }
          __syncthreads(); }
#if (DUP_MASK >> 10) & 1
_Pragma("unroll") for (int rep_ = 0; rep_ < 2; ++rep_)
#endif
        {
        IDS();
        unsigned char* ws = KWS(unsigned char, 0);
        pg8::MoeOrder S{tbl, 4, F.G, (int)blockIdx.x};
        pg8::EpiSwiGLU E{(const float*)(ws + WS_ROUTE + RT_ERS), (const float*)(ws + WS_ROUTE + RT_EW), (bf16*)(ws + WS_HID), tbl};
        pg8::gemm_phase<pg8::EpiSwiGLU, pg8::MoeOrder, D, D, D, true>(F.lds + RING_OFF, F.wave, (const bf16*)(ws + WS_TB), (const bf16*)(ws + WS_WGU), S, E, gidx);
        GRID_BAR();
        }
    }
#if (DUP_MASK >> 11) & 1
_Pragma("unroll") for (int rep_ = 0; rep_ < 2; ++rep_)
#endif
    {
        IDS();
        unsigned char* ws = KWS(unsigned char, 0);
        pg8::MoeOrder S{tbl, 8, F.G, (int)blockIdx.x}; pg8::EpiDown E{(bf16*)(ws + WS_O)};
        pg8::gemm_phase<pg8::EpiDown, pg8::MoeOrder, DFF, DFF, DFF>(F.lds + RING_OFF, F.wave, (const bf16*)(ws + WS_HID), (const bf16*)(ws + WS_WD), S, E);
        GRID_BAR();
    }
#if (DUP_MASK >> 12) & 1
_Pragma("unroll") for (int rep12_ = 0; rep12_ < 2; ++rep12_)
#endif
    {
        IDS();
        float* outp = KOUT(); const float* g_final = KIN(26);
        unsigned char* ws = KWS(unsigned char, 0); const unsigned* REC = (const unsigned*)(ws + WS_ROUTE + RT_REC); const bf16* OB = (const bf16*)(ws + WS_O); const bf16* TBp = (const bf16*)(ws + WS_TB);
        for (int m0 = gw; m0 < M_TOK; m0 += 2 * NGW) {
            f32x4 v[2][8]; float s[2];
#pragma unroll
            for (int q = 0; q < 2; ++q) { const int m = m0 + q * NGW;
                const v4u rc = *(const GAS v4u*)(REC + (size_t)m * 4);
                const unsigned s0 = (unsigned)tbl[rc.x] * 256u + rc.y, s1 = (unsigned)tbl[rc.z] * 256u + rc.w;
                const GAS v2u* xr = (const GAS v2u*)(TBp + (size_t)m * D) + lane; const GAS v2u* o0 = (const GAS v2u*)(OB + (size_t)s0 * D) + lane; const GAS v2u* o1 = (const GAS v2u*)(OB + (size_t)s1 * D) + lane;
                s[q] = 0.f;
#pragma unroll
                for (int j = 0; j < 8; ++j) { const v2u xw = xr[64 * j], a = o0[64 * j], c = o1[64 * j];
                    v[q][j].x = pg8::bf_lo(xw.x) + pg8::bf_lo(a.x) + pg8::bf_lo(c.x); v[q][j].y = pg8::bf_hi(xw.x) + pg8::bf_hi(a.x) + pg8::bf_hi(c.x);
                    v[q][j].z = pg8::bf_lo(xw.y) + pg8::bf_lo(a.y) + pg8::bf_lo(c.y); v[q][j].w = pg8::bf_hi(xw.y) + pg8::bf_hi(a.y) + pg8::bf_hi(c.y);
                    s[q] += dot4(v[q][j]); } }
#pragma unroll
            for (int q = 0; q < 2; ++q) { const int m = m0 + q * NGW; const float rstd = 1.f / sqrtf(wave_sum(s[q]) * (1.f / D) + EPS);
                GAS f32x4* orow = (GAS f32x4*)(outp + (size_t)m * D) + lane;
#pragma unroll
                for (int j = 0; j < 8; ++j) { const f32x4 gv = ((const GAS f32x4*)g_final)[lane + 64 * j]; orow[64 * j] = v[q][j] * rstd * gv; } }
        }
#if (DUP_MASK >> 12) & 1
        GRID_BAR();
#endif
    }
}

extern "C" void kernel_launch(void* const* d_in, const int* in_sizes, int n_in, void* d_out, int out_size, void* d_ws, size_t ws_size, hipStream_t stream) {
    static int grid = 0;
    if (grid == 0) {
        if (n_in != 27 || in_sizes[0] != M_TOK * D || out_size != M_TOK * D || ws_size < WS_END) { fprintf(stderr, "kernel_launch: unexpected shapes (n_in %d, in0 %d, out %d, ws %zu < %zu)\n", n_in, n_in > 0 ? in_sizes[0] : -1, out_size, ws_size, (size_t)WS_END); grid = -1; return; }
        int dev = 0, cus = 0, per_cu = 0;
        if (hipGetDevice(&dev) != hipSuccess || hipDeviceGetAttribute(&cus, hipDeviceAttributeMultiprocessorCount, dev) != hipSuccess) { grid = -1; return; }
        if (hipFuncSetAttribute((const void*)hymba_fwd, hipFuncAttributeMaxDynamicSharedMemorySize, LDS_BYTES) != hipSuccess) { fprintf(stderr, "kernel_launch: hipFuncSetAttribute failed\n"); grid = -1; return; }
        if (hipOccupancyMaxActiveBlocksPerMultiprocessor(&per_cu, (const void*)hymba_fwd, NWAVES * 64, LDS_BYTES) != hipSuccess || per_cu < 1)
            fprintf(stderr, "kernel_launch: note: occupancy query reports %d workgroups per CU\n", per_cu);
        (void)hipGetLastError();
        if (cus != 256) { fprintf(stderr, "kernel_launch: built for a 256-CU device (one workgroup per CU, 256 SSM / attention units), found %d\n", cus); grid = -1; return; }
        grid = cus;
    }
    if (grid < 0) return;
    if (hipMemsetAsync((char*)d_ws + WS_CTL, 0, CTL_ZERO_BYTES, stream) != hipSuccess) return;
    Args a{};
    for (int i = 0; i < 27; ++i) a.in[i] = (const float*)d_in[i];
    a.out = (float*)d_out; a.ws = (unsigned char*)d_ws;
    hipLaunchKernelGGL(hymba_fwd, dim3(grid), dim3(NWAVES * 64), LDS_BYTES, stream, a);
}
```

```cpp
#include <hip/hip_runtime.h>
#include <cstdio>
#include <cstdint>
namespace pg8 {
#define PG8_LAS __attribute__((address_space(3)))
typedef unsigned short bf16_t;
typedef short bf16x8 __attribute__((ext_vector_type(8)));
typedef float f32x4 __attribute__((ext_vector_type(4)));
typedef float f32x2 __attribute__((ext_vector_type(2)));
typedef unsigned u32x4 __attribute__((ext_vector_type(4)));
typedef unsigned u32x2 __attribute__((ext_vector_type(2)));
constexpr int BM = 256, BK = 64, HALF = 128, HTB = HALF * BK * 2  , STAGE_BYTES = 8 * HTB, NXCD = 8, WGM = 8;

__host__ __device__ __forceinline__ int lds_byte(int r, int c) { const int st = (r >> 4) * 2 + (c >> 5), rr = r & 15, cc = c & 31, ob = rr * 64 + cc * 2; return st * 1024 + (ob ^ (((ob >> 9) & 1) << 5)); }
__host__ __device__ __forceinline__ void stage_rc(int b, int& R, int& C) { const int st = b / 1024, sb = b % 1024, swz = sb ^ (((sb >> 9) & 1) << 5); R = (st >> 1) * 16 + swz / 64; C = (st & 1) * 32 + (swz % 64) / 2; }
__host__ __device__ __forceinline__ int perm32(int rho) { const int n = rho >> 4, i = rho & 15; return 8 * (i >> 2) + 4 * n + (i & 3); }

struct Unit { int pm, pn, ord; };

struct StaticOrder {
    int nM, nN, nwg, G, c, nx;
    __host__ __device__ void init(int M, int N, int G_, int c_, int nx_ = NXCD) { nM = M / BM; nN = N / BM; nwg = nM * nN; G = G_; c = c_; nx = nx_; }
    __host__ __device__ bool next(int i, Unit& u) const {
        const long L = (long)i * G + c; if (L >= nwg) return false;
        int wgid = (int)L; { const int q = nwg / nx, r = nwg % nx, xcd = wgid % nx, off = wgid / nx; wgid = (xcd < r ? xcd * (q + 1) : r * (q + 1) + (xcd - r) * q) + off; }
        const int nig = WGM * nN, gid = wgid / nig, fm = gid * WGM, gsz = (nM - fm) < WGM ? (nM - fm) : WGM;
        u.pm = fm + ((wgid % nig) % gsz); u.pn = (wgid % nig) / gsz; return true;
    }
    __device__ __forceinline__ void a_ready(const Unit&) const {}
    __device__ __forceinline__ void done(const Unit&) const {}
};
struct OneUnit {
    int pm, pn;
    __device__ bool next(int i, Unit& u) const { if (i > 0) return false; u.pm = pm; u.pn = pn; return true; }
};
struct MoeOrder {
    const PG8_LAS int* tb; int ntn, G, c;
    __device__ bool next(int i, Unit& u) const {
        const int L = i * G + c, NT = tb[32]; if (L >= NT * ntn) return false;
        const int tt = L / ntn, nt = L - tt * ntn; int E = 0;
#pragma unroll
        for (int e = 1; e < 32; ++e) E += (tt >= tb[e]) ? 1 : 0;
        u.pm = tt; u.pn = __builtin_amdgcn_readfirstlane(E * ntn + nt); return true;
    }
};

__device__ __forceinline__ int lane_id_() { int l; asm volatile("v_mbcnt_lo_u32_b32 %0, -1, 0\n\tv_mbcnt_hi_u32_b32 %0, -1, %0" : "=v"(l)); return l; }
__device__ __forceinline__ unsigned cvt_pk_bf16(float lo, float hi) { unsigned r; asm volatile("v_cvt_pk_bf16_f32 %0, %1, %2" : "=v"(r) : "v"(lo), "v"(hi)); return r; }
__device__ __forceinline__ u32x4 pack8(const f32x4 a, const f32x4 b) { u32x4 w; w.x = cvt_pk_bf16(a[0], a[1]); w.y = cvt_pk_bf16(a[2], a[3]); w.z = cvt_pk_bf16(b[0], b[1]); w.w = cvt_pk_bf16(b[2], b[3]); return w; }
__device__ __forceinline__ float bf_lo(unsigned w) { return __uint_as_float(w << 16); }
__device__ __forceinline__ float bf_hi(unsigned w) { return __uint_as_float(w & 0xffff0000u); }
__device__ __forceinline__ float sigmoidf_(float v) { return __builtin_amdgcn_rcpf(1.0f + __builtin_amdgcn_exp2f(-1.4426950408889634f * v)); }
__device__ __forceinline__ float gelu_tanh_(float v) { const float z = v + 0.044715f * v * v * v; return v * __builtin_amdgcn_rcpf(1.0f + __builtin_amdgcn_exp2f(-2.3022081982f * z)); }

constexpr float QSCALE = 0.125f * 1.4426950408889634f;

struct EpiInProj {
    static constexpr bool PERM = true, MIDK = false;
    bf16_t* Q; bf16_t* KV; bf16_t* UX;
    __device__ __forceinline__ void operator()(const f32x4 (&acc)[2][2][4][2], const Unit& u, int wr, int wc, int fr, int fq) const {
        const int row0 = u.pm * BM + wr * 64 + fr, cw = wc * 32 + 8 * fq;
#pragma unroll
        for (int ai = 0; ai < 2; ++ai)
#pragma unroll
            for (int m = 0; m < 4; ++m) { const int row = row0 + ai * HALF + m * 16;
#pragma unroll
                for (int bj = 0; bj < 2; ++bj) { f32x4 v0 = acc[ai][bj][m][0], v1 = acc[ai][bj][m][1]; const int ct = bj * HALF + cw;
                    if (u.pn < 4) { v0 = v0 * QSCALE; v1 = v1 * QSCALE; *(u32x4*)(Q + (size_t)row * 1024 + u.pn * 256 + ct) = pack8(v0, v1); }
                    else if (u.pn == 4) { *(u32x4*)(KV + (size_t)row * 256 + ct) = pack8(v0, v1); }
                    else { const int ch = (u.pn - 5) * 256 + ct, g = ch >> 4, hi0 = ch & 15;
                        *(u32x4*)(UX + ((size_t)(g * 1024 + (row >> 4)) * 384 + (row & 15) * 16 + hi0)) = pack8(v0, v1); } } }
    }
};
struct EpiS {
    static constexpr bool PERM = false, MIDK = false;
    float* S;
    __device__ __forceinline__ void operator()(const f32x4 (&acc)[2][2][4][2], const Unit& u, int wr, int wc, int fr, int fq) const {
        const int row0 = u.pm * BM + wr * 64 + fr, col0 = wc * 32 + 4 * fq;
#pragma unroll
        for (int ai = 0; ai < 2; ++ai)
#pragma unroll
            for (int m = 0; m < 4; ++m) { float* rowp = S + (size_t)(row0 + ai * HALF + m * 16) * 128 + col0;
#pragma unroll
                for (int n = 0; n < 2; ++n) *(f32x4*)(rowp + n * 16) = acc[ai][0][m][n]; }
    }
};
struct EpiY {
    static constexpr bool PERM = true, MIDK = false;
    bf16_t* YG;
    __device__ __forceinline__ void operator()(const f32x4 (&acc)[2][2][4][2], const Unit& u, int wr, int wc, int fr, int fq) const {
        const int g = u.pm >> 2, s0 = (u.pm & 3) * 256 + wr * 64 + fr, cw = wc * 32 + 8 * fq;
#pragma unroll
        for (int ai = 0; ai < 2; ++ai)
#pragma unroll
            for (int m = 0; m < 4; ++m) { const int stream = s0 + ai * HALF + m * 16;
#pragma unroll
                for (int bj = 0; bj < 2; ++bj) { const int n = bj * HALF + cw, tau = n >> 4, ho0 = n & 15; f32x4 v0 = acc[ai][bj][m][0], v1 = acc[ai][bj][m][1];
#pragma unroll
                    for (int e = 0; e < 4; ++e) { v0[e] = gelu_tanh_(v0[e]); v1[e] = gelu_tanh_(v1[e]); }
                    *(u32x4*)(YG + (size_t)(stream * 16 + tau) * 1024 + g * 16 + ho0) = pack8(v0, v1); } }
    }
};
struct EpiGLU {
    static constexpr bool PERM = true, MIDK = false;
    const bf16_t* YG; const float* bias; bf16_t* SG; float* RS;
    __device__ __forceinline__ void operator()(const f32x4 (&acc)[2][2][4][2], const Unit& u, int wr, int wc, int fr, int fq) const {
        const int row0 = u.pm * BM + wr * 64 + fr, col0 = u.pn * BM + wc * 32 + 8 * fq;
        f32x4 bv[2][2];
#pragma unroll
        for (int bj = 0; bj < 2; ++bj)
#pragma unroll
            for (int n = 0; n < 2; ++n) bv[bj][n] = *(const f32x4*)(bias + col0 + bj * HALF + 4 * n);
#pragma unroll
        for (int ai = 0; ai < 2; ++ai)
#pragma unroll
            for (int m = 0; m < 4; ++m) { const int row = row0 + ai * HALF + m * 16; float ss = 0.f;
#pragma unroll
                for (int bj = 0; bj < 2; ++bj) { const size_t off = (size_t)row * 1024 + col0 + bj * HALF, offs = (size_t)row * 2048 + 1024 + col0 + bj * HALF; const u32x4 yw = *(const u32x4*)(YG + off);
                    const f32x4 a0 = acc[ai][bj][m][0] + bv[bj][0], a1 = acc[ai][bj][m][1] + bv[bj][1]; f32x4 o0, o1;
                    o0[0] = bf_lo(yw.x) * sigmoidf_(a0[0]); o0[1] = bf_hi(yw.x) * sigmoidf_(a0[1]); o0[2] = bf_lo(yw.y) * sigmoidf_(a0[2]); o0[3] = bf_hi(yw.y) * sigmoidf_(a0[3]);
                    o1[0] = bf_lo(yw.z) * sigmoidf_(a1[0]); o1[1] = bf_hi(yw.z) * sigmoidf_(a1[1]); o1[2] = bf_lo(yw.w) * sigmoidf_(a1[2]); o1[3] = bf_hi(yw.w) * sigmoidf_(a1[3]);
                    ss += (o0[0] * o0[0] + o0[1] * o0[1]) + (o0[2] * o0[2] + o0[3] * o0[3]) + (o1[0] * o1[0] + o1[1] * o1[1]) + (o1[2] * o1[2] + o1[3] * o1[3]);
                    *(u32x4*)(SG + offs) = pack8(o0, o1); }
                ss += __shfl_xor(ss, 16); ss += __shfl_xor(ss, 32);
                if (fq == 0) RS[(size_t)row * 16 + u.pn * 4 + wc] = ss; }
    }
};
struct EpiXmid {
    static constexpr bool PERM = true, MIDK = true;
    const float* X; bf16_t* T; const PG8_LAS f32x2* sc;
    __device__ __forceinline__ void midk(f32x4 (&acc)[2][2][4][2], const Unit& u, int wr, int fr) const {
#pragma unroll
        for (int ai = 0; ai < 2; ++ai)
#pragma unroll
            for (int m = 0; m < 4; ++m) { const float q = sc[u.ord * 256 + ai * HALF + wr * 64 + m * 16 + fr].x;
#pragma unroll
                for (int bj = 0; bj < 2; ++bj)
#pragma unroll
                    for (int n = 0; n < 2; ++n) acc[ai][bj][m][n] = acc[ai][bj][m][n] * q; }
    }
    __device__ __forceinline__ void operator()(const f32x4 (&acc)[2][2][4][2], const Unit& u, int wr, int wc, int fr, int fq) const {
        const int row0 = u.pm * BM + wr * 64 + fr, col0 = u.pn * BM + wc * 32 + 8 * fq;
#pragma unroll
        for (int ai = 0; ai < 2; ++ai)
#pragma unroll
            for (int m = 0; m < 4; ++m) { const size_t off = (size_t)(row0 + ai * HALF + m * 16) * 2048 + col0; const float rs = sc[u.ord * 256 + ai * HALF + wr * 64 + m * 16 + fr].y;
#pragma unroll
                for (int bj = 0; bj < 2; ++bj) { const size_t o = off + bj * HALF; const f32x4 x0 = *(const f32x4*)(X + o), x1 = *(const f32x4*)(X + o + 4);
                    *(u32x4*)(T + o) = pack8(x0 + acc[ai][bj][m][0] * rs, x1 + acc[ai][bj][m][1] * rs); } }
    }
};
struct EpiSwiGLU {
    static constexpr bool PERM = true, MIDK = false;
    const float* ers; const float* ew; bf16_t* HID; const PG8_LAS int* tb;
    __device__ __forceinline__ void operator()(const f32x4 (&acc)[2][2][4][2], const Unit& u, int wr, int wc, int fr, int fq) const {
        const int Ex = u.pn >> 2, lb = Ex * 16384 + (u.pm - tb[Ex]) * 256 + wr * 64 + fr;
        const int row0 = u.pm * BM + wr * 64 + fr, col0 = (u.pn & 3) * 128 + wc * 32 + 8 * fq;
#pragma unroll
        for (int ai = 0; ai < 2; ++ai)
#pragma unroll
            for (int m = 0; m < 4; ++m) { const int slot = row0 + ai * HALF + m * 16, li = lb + ai * HALF + m * 16; const float rs = ers[li], w = ew[li]; f32x4 o[2];
#pragma unroll
                for (int n = 0; n < 2; ++n)
#pragma unroll
                    for (int e = 0; e < 4; ++e) { const float gt = acc[ai][0][m][n][e] * rs, up = acc[ai][1][m][n][e] * rs; o[n][e] = gt * sigmoidf_(gt) * up * w; }
                *(u32x4*)(HID + (size_t)slot * 512 + col0) = pack8(o[0], o[1]); }
    }
};
struct EpiDown {
    static constexpr bool PERM = true, MIDK = false;
    bf16_t* O;
    __device__ __forceinline__ void operator()(const f32x4 (&acc)[2][2][4][2], const Unit& u, int wr, int wc, int fr, int fq) const {
        const int row0 = u.pm * BM + wr * 64 + fr, col0 = (u.pn & 7) * 256 + wc * 32 + 8 * fq;
#pragma unroll
        for (int ai = 0; ai < 2; ++ai)
#pragma unroll
            for (int m = 0; m < 4; ++m) { bf16_t* rowp = O + (size_t)(row0 + ai * HALF + m * 16) * 2048 + col0;
#pragma unroll
                for (int bj = 0; bj < 2; ++bj) *(u32x4*)(rowp + bj * HALF) = pack8(acc[ai][bj][m][0], acc[ai][bj][m][1]); }
    }
};

template <class Epi, class Sched, int K, int LDA, int LDB, bool GATHER = false>
__device__ __forceinline__ void gemm_phase(PG8_LAS unsigned char* lds, int wave_id, const bf16_t* Ab, const bf16_t* Bb, const Sched& S, const Epi& E, const PG8_LAS int* gidx = nullptr) {
    int tid_ = wave_id * 64 + lane_id_(); asm volatile("" : "+v"(tid_));
    const int tid = tid_, wid = wave_id, lane = tid & 63, wr = wid >> 2, wc = wid & 3, fr = lane & 15, fq = lane >> 4;
    constexpr int nt = K / BK;
    static_assert(K % 128 == 0 && K >= 256, "K multiple of 128, >= 256");
    unsigned voffA[2], voffB[2], voffG[2][2];
#pragma unroll
    for (int i = 0; i < 2; ++i) { int R, C; stage_rc(tid * 16 + i * 8192, R, C); const int Rb = Epi::PERM ? ((R & ~31) + perm32(R & 31)) : R;
        voffA[i] = (unsigned)(R * LDA + C) * 2u; voffB[i] = (unsigned)(Rb * LDB + C) * 2u; voffG[0][i] = 0u; voffG[1][i] = 0u; }
    constexpr size_t kstep = (size_t)(BK * 2);
    constexpr size_t hstepA = GATHER ? 0 : (size_t)HALF * LDA * 2, hstepB = (size_t)HALF * LDB * 2;
    constexpr size_t tstepA = 2 * hstepA, tstepB = 2 * hstepB;
    const unsigned ldsw = (unsigned)wid * 1024u;
    const int aoff = lds_byte(wr * 64 + fr, fq * 8), boff = lds_byte(wc * 32 + fr, fq * 8);
#define PG8_SA(b, h) (((b) * 2 + (h)) * HTB)
#define PG8_SB(b, h) ((4 + (b) * 2 + (h)) * HTB)
#define PG8_STAGE(bufoff, gbase, voff) do { _Pragma("unroll") for (int _i = 0; _i < 2; ++_i) \
        __builtin_amdgcn_global_load_lds((const unsigned*)((const char*)(gbase) + (voff)[_i]), (PG8_LAS unsigned*)(lds + (bufoff) + ldsw + _i * 8192), 16, 0, 0); } while (0)
#define PG8_STA(b, h, ptr) do { if constexpr (GATHER) PG8_STAGE(PG8_SA(b, h), ptr, voffG[h]); else PG8_STAGE(PG8_SA(b, h), (ptr) + (h) * hstepA, voffA); } while (0)
#define PG8_LOADG(uord) do { _Pragma("unroll") for (int _h = 0; _h < 2; ++_h) _Pragma("unroll") for (int _i = 0; _i < 2; ++_i) { int R_, C_; stage_rc(tid * 16 + _i * 8192, R_, C_); \
        const int tok_ = gidx[(uord) * 256 + _h * 128 + R_]; voffG[_h][_i] = (unsigned)(tok_ * LDA + C_) * 2u; } } while (0)
#define PG8_LDA(dst, b, h) do { _Pragma("unroll") for (int m = 0; m < 4; ++m) _Pragma("unroll") for (int k = 0; k < 2; ++k) dst[m][k] = *(const PG8_LAS bf16x8*)(lds + PG8_SA(b, h) + aoff + m * 2048 + k * 1024); } while (0)
#define PG8_LDB(dst, b, h) do { _Pragma("unroll") for (int n = 0; n < 2; ++n) _Pragma("unroll") for (int k = 0; k < 2; ++k) dst[n][k] = *(const PG8_LAS bf16x8*)(lds + PG8_SB(b, h) + boff + n * 2048 + k * 1024); } while (0)
#define PG8_MMA(ai, bj, At, Bt) do { __builtin_amdgcn_s_setprio(1); _Pragma("unroll") for (int m = 0; m < 4; ++m) _Pragma("unroll") for (int n = 0; n < 2; ++n) _Pragma("unroll") for (int k = 0; k < 2; ++k) \
        acc[ai][bj][m][n] = __builtin_amdgcn_mfma_f32_16x16x32_bf16(Bt[n][k], At[m][k], acc[ai][bj][m][n], 0, 0, 0); __builtin_amdgcn_s_setprio(0); } while (0)
#define PG8_WAIT_V(n) asm volatile("s_waitcnt vmcnt(" #n ")" ::: "memory")
#define PG8_WAIT_L(n) asm volatile("s_waitcnt lgkmcnt(" #n ")" ::: "memory")
#define PG8_BAR __builtin_amdgcn_s_barrier()
#define PG8_SCHED __builtin_amdgcn_sched_barrier(0)
    Unit cur, nxt; int ui = 0;
    if (!S.next(0, cur)) return;
    cur.ord = 0;
    f32x4 acc[2][2][4][2];
#pragma unroll
    for (int a = 0; a < 2; ++a)
#pragma unroll
        for (int b = 0; b < 2; ++b)
#pragma unroll
            for (int m = 0; m < 4; ++m)
#pragma unroll
                for (int n = 0; n < 2; ++n) acc[a][b][m][n] = (f32x4){0.f, 0.f, 0.f, 0.f};
    bf16x8 At[4][2], B0[2][2], B1[2][2];
    const char* cA = (const char*)Ab + (size_t)cur.pm * tstepA; const char* cB = (const char*)Bb + (size_t)cur.pn * tstepB;
    if constexpr (GATHER) { PG8_LOADG(0); }
    PG8_STAGE(PG8_SB(0, 0), cB, voffB); PG8_STAGE(PG8_SB(0, 1), cB + hstepB, voffB); PG8_STA(0, 0, cA); PG8_STA(0, 1, cA);
    if (wr == 1) PG8_BAR;
    PG8_WAIT_V(2); PG8_BAR;
    PG8_STAGE(PG8_SB(1, 0), cB + kstep, voffB); PG8_STA(1, 0, cA + kstep); PG8_STAGE(PG8_SB(1, 1), cB + hstepB + kstep, voffB);
    PG8_WAIT_V(6); PG8_BAR;
    for (;;) {
        const bool has_next = S.next(ui + 1, nxt); nxt.ord = ui + 1;
        const char* nA = has_next ? (const char*)Ab + (size_t)nxt.pm * tstepA : cA; const char* nB = has_next ? (const char*)Bb + (size_t)nxt.pn * tstepB : cB;
        for (int t = 0; t < nt; t += 2) {
            const bool last = (t == nt - 2);
            const char* a1 = cA + (size_t)(t + 1) * kstep;
            const char* a2 = last ? nA : cA + (size_t)(t + 2) * kstep; const char* b2 = last ? nB : cB + (size_t)(t + 2) * kstep;
            const char* a3 = a2 + kstep; const char* b3 = b2 + kstep;
            if constexpr (Epi::MIDK) { if (t == nt / 2) E.midk(acc, cur, wr, fr); }
            PG8_LDB(B0, 0, 0); PG8_LDB(B1, 0, 1); PG8_SCHED; PG8_LDA(At, 0, 0); PG8_STA(1, 1, a1);
            if constexpr (GATHER) { if (last && has_next) { PG8_LOADG(ui + 1); } }
            PG8_WAIT_V(8); PG8_WAIT_L(0); PG8_BAR; PG8_MMA(0, 0, At, B0); PG8_MMA(0, 1, At, B1); PG8_BAR; PG8_SCHED;
            PG8_LDA(At, 0, 1); PG8_STAGE(PG8_SB(0, 0), b2, voffB); PG8_STAGE(PG8_SB(0, 1), b2 + hstepB, voffB); PG8_STA(0, 0, a2);
            PG8_WAIT_V(8); PG8_WAIT_L(0); PG8_BAR; PG8_MMA(1, 0, At, B0); PG8_MMA(1, 1, At, B1); PG8_BAR; PG8_SCHED;
            PG8_LDB(B0, 1, 0); PG8_LDB(B1, 1, 1); PG8_SCHED; PG8_LDA(At, 1, 0); PG8_STA(0, 1, a2);
            PG8_WAIT_V(8); PG8_WAIT_L(0); PG8_BAR; PG8_MMA(0, 0, At, B0); PG8_MMA(0, 1, At, B1); PG8_BAR; PG8_SCHED;
            PG8_LDA(At, 1, 1); PG8_STAGE(PG8_SB(1, 0), b3, voffB); PG8_STAGE(PG8_SB(1, 1), b3 + hstepB, voffB); PG8_STA(1, 0, a3);
            PG8_WAIT_V(8); PG8_WAIT_L(0); PG8_BAR; PG8_MMA(1, 0, At, B0); PG8_MMA(1, 1, At, B1); PG8_BAR; PG8_SCHED;
        }
        if (wr == 0) PG8_BAR;
        E(acc, cur, wr, wc, fr, fq);
        if (!has_next) break;
#pragma unroll
        for (int a = 0; a < 2; ++a)
#pragma unroll
            for (int b = 0; b < 2; ++b)
#pragma unroll
                for (int m = 0; m < 4; ++m)
#pragma unroll
                    for (int n = 0; n < 2; ++n) acc[a][b][m][n] = (f32x4){0.f, 0.f, 0.f, 0.f};
        cur = nxt; cA = nA; cB = nB; ++ui;
        if (wr == 1) PG8_BAR;
    }
    PG8_WAIT_V(0);
    PG8_BAR;
#undef PG8_SA
#undef PG8_SB
#undef PG8_STAGE
#undef PG8_STA
#undef PG8_LOADG
#undef PG8_LDA
#undef PG8_LDB
#undef PG8_MMA
#undef PG8_WAIT_V
#undef PG8_WAIT_L
#undef PG8_BAR
#undef PG8_SCHED
}
}

constexpr int NWAVES = 8;
constexpr int M_TOK = 16384, D = 2048, SEQ = 4096, NB_ = 4;
constexpr int NPROJ = 2304, DATT = 1024, DSSM = 1024;
constexpr int NEXP = 32, DFF = 512, NRT = 48;
constexpr int MAXTILES = 160, MAXSLOTS = MAXTILES * 256;
constexpr float EPS = 1e-6f;
constexpr float LOG2E = 1.4426950408889634f;

constexpr size_t MiB = 1u << 20;
constexpr size_t WS_CTL = 0, CTL_ZERO_BYTES = 1 * MiB;
constexpr size_t WS_SMALL = 1 * MiB;
constexpr size_t SM_A16 = 0, SM_ONES = 32 * 1024, SM_GCAT = 40 * 1024, SM_WRH = 64 * 1024, SM_WRL = SM_WRH + (size_t)NRT * D * 2;
constexpr size_t WS_WIN = 2 * MiB, WS_WGLU = 11 * MiB, WS_WOUT = 13 * MiB, WS_TE = 21 * MiB, WS_WP = 33 * MiB, WS_WGU = 41 * MiB, WS_WD = 169 * MiB;
constexpr size_t WS_XN = 233 * MiB, WS_Q = 297 * MiB, WS_KV = 329 * MiB, WS_UX = 337 * MiB;
constexpr size_t WS_S = 233 * MiB, WS_ATT = 265 * MiB;
constexpr size_t WS_RSA = 385 * MiB, WS_RSS = 386 * MiB;
constexpr size_t WS_YG = 387 * MiB, WS_SG = 419 * MiB, WS_MIX = 451 * MiB;
constexpr size_t WS_TB = 233 * MiB, WS_HID = 457 * MiB, WS_O = 297 * MiB, WS_ROUTE = 497 * MiB;
constexpr size_t RT_REC = 0, RT_ETOK = 1 * MiB, RT_EW = 3 * MiB, RT_ERS = 5 * MiB;
constexpr size_t WS_END = 515 * MiB;
static_assert(WS_O + (size_t)MAXSLOTS * D * 2 <= WS_HID && WS_HID + (size_t)MAXSLOTS * DFF * 2 <= WS_ROUTE && WS_ROUTE + 7 * MiB <= WS_END, "d_ws map");
constexpr int CW_TMO = 0, CW_CODE = 1;
constexpr int CW_BAR = 4096;
constexpr int CW_CNT = 16384;
constexpr int CW_Q0 = 32768, CW_Q1 = 34816;

constexpr int RING_OFF = 0, RING_BYTES = 131072;
constexpr int LDSCTL_OFF = RING_BYTES, MISC_OFF = LDSCTL_OFF + 320, TB_OFF = LDSCTL_OFF + 1024;
constexpr int SC_OFF = LDSCTL_OFF + 10240;
constexpr int GIDX_OFF = LDSCTL_OFF + 2048;
constexpr int LDS_BYTES = 147456;

#define GAS __attribute__((address_space(1)))
#define LAS __attribute__((address_space(3)))
typedef unsigned short bf16;
typedef unsigned v4u __attribute__((ext_vector_type(4)));
typedef unsigned v2u __attribute__((ext_vector_type(2)));
typedef float f32x4 __attribute__((ext_vector_type(4)));
typedef float f32x16 __attribute__((ext_vector_type(16)));
typedef short bf16x8 __attribute__((ext_vector_type(8)));
typedef GAS unsigned gu32;
#define RLX_AGENT __ATOMIC_RELAXED, __HIP_MEMORY_SCOPE_AGENT
#define LDS_WAIT() asm volatile("s_waitcnt lgkmcnt(0)" ::: "memory")
#define VM_WAIT() asm volatile("s_waitcnt vmcnt(0)" ::: "memory")
__device__ __forceinline__ unsigned f2bf(float f) { unsigned u = __builtin_bit_cast(unsigned, f); return (u + 0x7fffu + ((u >> 16) & 1u)) >> 16; }
__device__ __forceinline__ unsigned pk2(float lo, float hi) { return f2bf(lo) | (f2bf(hi) << 16); }
__device__ __forceinline__ float bf2f(unsigned h) { return __uint_as_float(h << 16); }

#define XB_TMO      128
#define XB_XCNT(j)  (256  + 64 * (j))
#define XB_XSUB(j)  (1280 + 64 * (j))
#define XB_XGEN(j)  (2304 + 64 * (j))
#define XB_TOP      3328
#define XB_TOPGEN   3392
#define XCD_BAR_WORDS 3456
#define XB_SPIN_CAP (1u << 18)

__device__ __forceinline__ unsigned xb_ld(unsigned* p)              { return __hip_atomic_load(p, __ATOMIC_RELAXED, __HIP_MEMORY_SCOPE_AGENT); }
__device__ __forceinline__ unsigned xb_add(unsigned* p, unsigned v) { return __hip_atomic_fetch_add(p, v, __ATOMIC_RELAXED, __HIP_MEMORY_SCOPE_AGENT); }
__device__ __forceinline__ unsigned xb_xcc_id() { return (unsigned)__builtin_amdgcn_s_getreg((3 << 11) | 20) & 0xFu; }
#define XB_SPIN(cond, bar) do { unsigned _sp = 0; while (cond) { __builtin_amdgcn_s_sleep(1); \
    if ((++_sp & 255u) == 0u) { if (xb_ld(&(bar)[XB_TMO])) break; if (_sp > XB_SPIN_CAP) { atomicAdd(&(bar)[XB_TMO], 1u); break; } } } } while (0)

struct XcdBarrier {
    unsigned* bar; unsigned x;
    volatile LAS unsigned* st;
};

__device__ __forceinline__ XcdBarrier xcd_barrier_post(unsigned* bar, volatile LAS unsigned* st, bool thread0) {
    XcdBarrier b; b.bar = bar; b.x = xb_xcc_id(); b.st = st;
    if (thread0) (void)xb_add(&bar[XB_XCNT(b.x)], 1u);
    return b;
}
__device__ __forceinline__ void xcd_barrier_complete(unsigned* bar, unsigned x, unsigned& nloc, unsigned& nx) {
    const unsigned G = gridDim.x * gridDim.y * gridDim.z;
    unsigned sum, cnt, mine, sp = 0u;
    for (;;) {
        sum = 0u; cnt = 0u; mine = 0u;
#pragma unroll
        for (unsigned j = 0; j < 16; ++j) { const unsigned c = xb_ld(&bar[XB_XCNT(j)]); sum += c; cnt += (c > 0u) ? 1u : 0u; mine = (j == x) ? c : mine; }
        if (sum == G) break;
        __builtin_amdgcn_s_sleep(1);
        if ((++sp & 255u) == 0u) { if (xb_ld(&bar[XB_TMO])) break; if (sp > XB_SPIN_CAP) { atomicAdd(&bar[XB_TMO], 1u); break; } }
    }
    nloc = mine > 0u ? mine : 1u; nx = cnt > 0u ? cnt : 1u;
}

__device__ __forceinline__ void xcd_barrier(const XcdBarrier& b, bool thread0) {
    asm volatile("s_waitcnt vmcnt(0)" ::: "memory");
    __syncthreads();
    if (thread0) {
        unsigned* bar = b.bar;
        __builtin_amdgcn_s_waitcnt(0);
        unsigned nloc = b.st[0], nx = b.st[1];
        if (nloc == 0u) { xcd_barrier_complete(bar, b.x, nloc, nx); b.st[0] = nloc; b.st[1] = nx; }
        const unsigned old = xb_add(&bar[XB_XSUB(b.x)], 1u);
        const unsigned gen = old / nloc;
        if (old + 1u == (gen + 1u) * nloc) {
            __builtin_amdgcn_fence(__ATOMIC_RELEASE, "agent");
            asm volatile("s_waitcnt vmcnt(0)" ::: "memory");
            const unsigned og = xb_add(&bar[XB_TOP], 1u);
            const unsigned tg = og / nx;
            if (og + 1u == (tg + 1u) * nx) xb_add(&bar[XB_TOPGEN], 1u);
            else XB_SPIN(xb_ld(&bar[XB_TOPGEN]) == tg, bar);
            __builtin_amdgcn_fence(__ATOMIC_ACQUIRE, "agent");
            xb_add(&bar[XB_XGEN(b.x)], 1u);
            asm volatile("s_waitcnt vmcnt(0)" ::: "memory");
        } else {
            XB_SPIN(xb_ld(&bar[XB_XGEN(b.x)]) == gen, bar);
            __builtin_amdgcn_fence(__ATOMIC_ACQUIRE, "agent");
            asm volatile("s_waitcnt vmcnt(0)" ::: "memory");
        }
    }
    __syncthreads();
}

struct Frame {
    LAS unsigned char* lds;
    volatile LAS unsigned* MISC;
    gu32* ctl;
    int wave;
    int vcu, G;
};
__device__ __forceinline__ float wave_sum(float v) {
#pragma unroll
    for (int o = 1; o < 64; o <<= 1) v += __shfl_xor(v, o);
    return v;
}
__device__ __forceinline__ float dot4(f32x4 a) { return (a.x * a.x + a.y * a.y) + (a.z * a.z + a.w * a.w); }

__device__ __forceinline__ void p0_transpose_item(const float* W, int N, bf16* WT, int ldk, size_t drow0, int k0, int n0, const float* kscale, LAS float* scr, int lane) {
#pragma unroll 8
    for (int i = 0; i < 32; ++i) { const int kk = 2 * i + (lane >> 5); scr[kk * 33 + (lane & 31)] = W[(size_t)(k0 + kk) * N + n0 + (lane & 31)]; }
    LDS_WAIT(); asm volatile("" ::: "memory");
    const int c = lane & 7;
    float sc[8];
#pragma unroll
    for (int j = 0; j < 8; ++j) sc[j] = kscale ? kscale[k0 + 8 * c + j] : 1.f;
#pragma unroll
    for (int j = 0; j < 4; ++j) { const int n = (lane >> 3) + 8 * j; const LAS float* s = scr + (8 * c) * 33 + n;
        v4u o; o.x = pk2(s[0 * 33] * sc[0], s[1 * 33] * sc[1]); o.y = pk2(s[2 * 33] * sc[2], s[3 * 33] * sc[3]); o.z = pk2(s[4 * 33] * sc[4], s[5 * 33] * sc[5]); o.w = pk2(s[6 * 33] * sc[6], s[7 * 33] * sc[7]);
        *(GAS v4u*)(WT + (drow0 + n) * (size_t)ldk + k0 + 8 * c) = o; }
    LDS_WAIT(); asm volatile("" ::: "memory");
}
struct TItem { const float* W; bf16* WT; const float* ks; int N, ldk, k0, n0; size_t drow0; };
template <bool SCALED, bool NT> __device__ __forceinline__ void titem_load(f32x4 (&rg)[8], f32x4 (&sc)[2], const TItem& t, int lane) {
    if constexpr (SCALED) { sc[0] = *(const GAS f32x4*)(t.ks + t.k0 + 8 * (lane & 7)); sc[1] = *(const GAS f32x4*)(t.ks + t.k0 + 8 * (lane & 7) + 4); } else { sc[0] = (f32x4){1.f, 1.f, 1.f, 1.f}; sc[1] = sc[0]; }
    const float* p = t.W + (size_t)(t.k0 + (lane >> 3)) * t.N + t.n0 + 4 * (lane & 7);
#pragma unroll
    for (int i = 0; i < 8; ++i) { if constexpr (NT) rg[i] = __builtin_nontemporal_load((const GAS f32x4*)(p + (size_t)(8 * i) * t.N)); else rg[i] = *(const GAS f32x4*)(p + (size_t)(8 * i) * t.N); }
}
template <bool NT> __device__ __forceinline__ void titem_finish(const f32x4 (&rg)[8], const f32x4 (&sc)[2], const TItem& t, LAS float* scr, int lane) {
#pragma unroll
    for (int i = 0; i < 8; ++i) { LAS float* d = scr + (8 * i + (lane >> 3)) * 33 + 4 * (lane & 7); d[0] = rg[i].x; d[1] = rg[i].y; d[2] = rg[i].z; d[3] = rg[i].w; }
    LDS_WAIT(); asm volatile("" ::: "memory");
    const int c = lane & 7;
#pragma unroll
    for (int j = 0; j < 4; ++j) { const int n = (lane >> 3) + 8 * j; const LAS float* s = scr + (8 * c) * 33 + n;
        v4u o; o.x = pk2(s[0 * 33] * sc[0].x, s[1 * 33] * sc[0].y); o.y = pk2(s[2 * 33] * sc[0].z, s[3 * 33] * sc[0].w); o.z = pk2(s[4 * 33] * sc[1].x, s[5 * 33] * sc[1].y); o.w = pk2(s[6 * 33] * sc[1].z, s[7 * 33] * sc[1].w);
        if constexpr (NT) __builtin_nontemporal_store(o, (GAS v4u*)(t.WT + (t.drow0 + n) * (size_t)t.ldk + t.k0 + 8 * c)); else *(GAS v4u*)(t.WT + (t.drow0 + n) * (size_t)t.ldk + t.k0 + 8 * c) = o; }
    LDS_WAIT(); asm volatile("" ::: "memory");
}
constexpr int IT_WGLU = 16 * 32, IT_WOUT = 32 * 64, IT_GU = 32 * 32 * 16, IT_DN = 32 * 8 * 64, NQ1 = IT_WGLU + IT_WOUT + 2 * IT_GU + IT_DN;
__device__ __forceinline__ TItem decode_q1(int r, const float* ones, const float* gcat, const float* w_glu, const float* w_out, const float* g_ffn, const float* w_gate, const float* w_up, const float* w_down, unsigned char* ws) {
    TItem t;
    if (r < IT_WGLU) { const int kb = r / 32, nb = r - kb * 32; t.W = w_glu; t.N = DSSM; t.WT = (bf16*)(ws + WS_WGLU); t.ldk = DSSM; t.drow0 = (size_t)32 * nb; t.k0 = 64 * kb; t.n0 = 32 * nb; t.ks = ones; return t; } r -= IT_WGLU;
    if (r < IT_WOUT) { const int kb = r / 64, nb = r - kb * 64; t.W = w_out; t.N = D; t.WT = (bf16*)(ws + WS_WOUT); t.ldk = D; t.drow0 = (size_t)32 * nb; t.k0 = 64 * kb; t.n0 = 32 * nb; t.ks = gcat; return t; } r -= IT_WOUT;
    if (r < 2 * IT_GU) { const int up = r >= IT_GU ? 1 : 0; const int r2 = r - up * IT_GU, E = r2 >> 9, q2 = r2 & 511, kb = q2 >> 4, nb = q2 & 15, f0 = 32 * nb;
        t.W = (up ? w_up : w_gate) + (size_t)E * D * DFF; t.N = DFF; t.WT = (bf16*)(ws + WS_WGU); t.ldk = D; t.drow0 = (size_t)E * 1024 + (f0 >> 7) * 256 + up * 128 + (f0 & 127); t.k0 = 64 * kb; t.n0 = f0; t.ks = g_ffn; return t; } r -= 2 * IT_GU;
    { const int E = r >> 9, q2 = r & 511, kb = q2 >> 6, nb = q2 & 63; t.W = w_down + (size_t)E * DFF * D; t.N = D; t.WT = (bf16*)(ws + WS_WD); t.ldk = DFF; t.drow0 = (size_t)E * D + 32 * nb; t.k0 = 64 * kb; t.n0 = 32 * nb; t.ks = ones; return t; }
}
__device__ __forceinline__ void rms_rows2_to_bf16(const float* xrow, const f32x4 (&gv)[8], bf16* orow, int lane) {
    const GAS f32x4* xr = (const GAS f32x4*)xrow + lane;
    f32x4 v[2][8]; float s0 = 0.f, s1 = 0.f;
#pragma unroll
    for (int j = 0; j < 8; ++j) v[0][j] = xr[64 * j];
#pragma unroll
    for (int j = 0; j < 8; ++j) v[1][j] = xr[512 + 64 * j];
#pragma unroll
    for (int j = 0; j < 8; ++j) s0 += dot4(v[0][j]);
#pragma unroll
    for (int j = 0; j < 8; ++j) s1 += dot4(v[1][j]);
#pragma unroll
    for (int o = 1; o < 64; o <<= 1) { s0 += __shfl_xor(s0, o); s1 += __shfl_xor(s1, o); }
    const float r0 = 1.f / sqrtf(s0 * (1.f / D) + EPS), r1 = 1.f / sqrtf(s1 * (1.f / D) + EPS);
    GAS unsigned long long* o8 = (GAS unsigned long long*)orow + lane;
#pragma unroll
    for (int j = 0; j < 8; ++j)
        o8[64 * j] = (unsigned long long)pk2(v[0][j].x * r0 * gv[j].x, v[0][j].y * r0 * gv[j].y) | ((unsigned long long)pk2(v[0][j].z * r0 * gv[j].z, v[0][j].w * r0 * gv[j].w) << 32);
#pragma unroll
    for (int j = 0; j < 8; ++j)
        o8[512 + 64 * j] = (unsigned long long)pk2(v[1][j].x * r1 * gv[j].x, v[1][j].y * r1 * gv[j].y) | ((unsigned long long)pk2(v[1][j].z * r1 * gv[j].z, v[1][j].w * r1 * gv[j].w) << 32);
}
__device__ __forceinline__ double exp_d(double x) {
    const double kf = __builtin_rint(x * 1.4426950408889634074); const double r = x - kf * 0.6931471805599453094;
    double p = 1.0;
#pragma unroll
    for (int i = 18; i >= 1; --i) p = 1.0 + r * p * (1.0 / (double)i);
    return __builtin_ldexp(p, (int)kf);
}
__device__ __forceinline__ void sincos_d(double th, double& sn, double& cs) {
    const double k = __builtin_rint(th * 0.15915494309189533577); const double r = th - k * 6.283185307179586477; const double r2 = r * r;
    double s = 1.0, c = 1.0;
#pragma unroll
    for (int i = 15; i >= 1; --i) { s = 1.0 - r2 * s * (1.0 / (double)((2 * i) * (2 * i + 1))); c = 1.0 - r2 * c * (1.0 / (double)((2 * i - 1) * (2 * i))); }
    sn = r * s; cs = c;
}
__device__ __forceinline__ void p0_ssm_tables(Frame& F, int g, int part, const float* lam_re, const float* lam_im, const float* log_dt, const float* b_re, const float* b_im,
                                              const float* c_re, const float* c_im, const float* d_skip, bf16* TE, bf16* WP, float* A16) {
    LAS float* Apr = (LAS float*)(F.lds);
    LAS float* Api = Apr + 17 * 64;
    LAS float* Bbr = Api + 17 * 64;
    LAS float* Bbi = Bbr + 1024;
    LAS float* Cr = Bbi + 1024;
    LAS float* Ci = Cr + 1024;
    LAS float* Dk = Ci + 1024;
    LAS float* Kt = Dk + 16;
    int tid = F.wave * 64 + pg8::lane_id_(); asm volatile("" : "+v"(tid));
    if (tid < 64) { const int p = tid;
        const double dt = exp_d((double)log_dt[g]); const double lr = (double)lam_re[g * 64 + p], li = (double)lam_im[g * 64 + p];
        const double mag = exp_d(lr * dt); double sn, cs; sincos_d(li * dt, sn, cs);
        const double ar = mag * cs, ai = mag * sn, den = lr * lr + li * li;
        const double cr = ((ar - 1.0) * lr + ai * li) / den, ci = (ai * lr - (ar - 1.0) * li) / den;
        double pr = 1.0, pi = 0.0;
        for (int t = 0; t < 17; ++t) { Apr[t * 64 + p] = (float)pr; Api[t * 64 + p] = (float)pi; const double nr = pr * ar - pi * ai, ni = pr * ai + pi * ar; pr = nr; pi = ni; }
        if (part == 0) { A16[(g * 64 + p) * 2 + 0] = Apr[16 * 64 + p]; A16[(g * 64 + p) * 2 + 1] = Api[16 * 64 + p]; }
        { const GAS f32x4* pbr = (const GAS f32x4*)(b_re + (g * 64 + p) * 16); const GAS f32x4* pbi = (const GAS f32x4*)(b_im + (g * 64 + p) * 16);
          const f32x4 r0 = pbr[0], r1 = pbr[1], r2 = pbr[2], r3 = pbr[3], i0 = pbi[0], i1 = pbi[1], i2 = pbi[2], i3 = pbi[3];
          const float brv[16] = {r0.x, r0.y, r0.z, r0.w, r1.x, r1.y, r1.z, r1.w, r2.x, r2.y, r2.z, r2.w, r3.x, r3.y, r3.z, r3.w};
          const float biv[16] = {i0.x, i0.y, i0.z, i0.w, i1.x, i1.y, i1.z, i1.w, i2.x, i2.y, i2.z, i2.w, i3.x, i3.y, i3.z, i3.w};
#pragma unroll
          for (int hh = 0; hh < 16; ++hh) { const double br = (double)brv[hh], bi = (double)biv[hh];
            Bbr[p * 16 + hh] = (float)(cr * br - ci * bi); Bbi[p * 16 + hh] = (float)(cr * bi + ci * br); } }
    }
    for (int i = tid; i < 1024; i += 512) { Cr[i] = c_re[g * 1024 + i]; Ci[i] = c_im[g * 1024 + i]; }
    if (tid < 16) Dk[tid] = d_skip[g * 16 + tid];
    __syncthreads();
    { const int t0 = tid >> 8, ho = (tid >> 4) & 15, hi = tid & 15; float kacc[8];
#pragma unroll
      for (int i = 0; i < 8; ++i) kacc[i] = 0.f;
#pragma unroll 4
      for (int p = 0; p < 64; ++p) { const float b_r = Bbr[p * 16 + hi], b_i = Bbi[p * 16 + hi], c_r = Cr[ho * 64 + p], c_i = Ci[ho * 64 + p];
          const float u_ = c_r * b_r - c_i * b_i, w_ = c_r * b_i + c_i * b_r;
#pragma unroll
          for (int i = 0; i < 8; ++i) kacc[i] += Apr[(t0 + 2 * i) * 64 + p] * u_ - Api[(t0 + 2 * i) * 64 + p] * w_; }
#pragma unroll
      for (int i = 0; i < 8; ++i) Kt[(t0 + 2 * i) * 260 + (tid & 255)] = kacc[i]; }
    __syncthreads();
#pragma unroll 2
    for (int i = 0; i < 6; ++i) { const int v = tid + 512 * i, nl = v / 48, kv = v - nl * 48, n = part * 64 + nl, tau = n >> 4, ho = n & 15; f32x4 va, vb;
        if (kv < 32) { const int s = kv >> 1, hi0 = (kv & 1) * 8, lag = tau - s; const LAS f32x4* kp = (const LAS f32x4*)(Kt + (lag < 0 ? 0 : lag) * 260 + ho * 16 + hi0);
            va = kp[0]; vb = kp[1]; if (lag < 0) { va = (f32x4){0.f, 0.f, 0.f, 0.f}; vb = va; }
            if (lag == 0) { const float dk = Dk[ho]; const int e = ho - hi0;
                if (e == 0) va.x += dk; if (e == 1) va.y += dk; if (e == 2) va.z += dk; if (e == 3) va.w += dk; if (e == 4) vb.x += dk; if (e == 5) vb.y += dk; if (e == 6) vb.z += dk; if (e == 7) vb.w += dk; }
        } else { const int pe0 = (kv - 32) * 8, p0 = pe0 & 63; const LAS f32x4* ar = (const LAS f32x4*)(Apr + (tau + 1) * 64 + p0); const LAS f32x4* ai = (const LAS f32x4*)(Api + (tau + 1) * 64 + p0);
            const LAS f32x4* cr = (const LAS f32x4*)(Cr + ho * 64 + p0); const LAS f32x4* ci = (const LAS f32x4*)(Ci + ho * 64 + p0);
            const f32x4 ar0 = ar[0], ar1 = ar[1], ai0 = ai[0], ai1 = ai[1], cr0 = cr[0], cr1 = cr[1], ci0 = ci[0], ci1 = ci[1];
            if (pe0 < 64) { va = cr0 * ar0 - ci0 * ai0; vb = cr1 * ar1 - ci1 * ai1; } else { va = -(cr0 * ai0 + ci0 * ar0); vb = -(cr1 * ai1 + ci1 * ar1); } }
        v4u o; o.x = pk2(va.x, va.y); o.y = pk2(va.z, va.w); o.z = pk2(vb.x, vb.y); o.w = pk2(vb.z, vb.w);
        *(GAS v4u*)(TE + ((size_t)(g * 256 + n)) * 384 + kv * 8) = o; }
#pragma unroll 2
    for (int i = 0; i < 4; ++i) { const int v = tid + 512 * i, nl = v >> 5, kv = v & 31, n = part * 64 + nl, s = kv >> 1, hi0 = (kv & 1) * 8; f32x4 va = (f32x4){0.f, 0.f, 0.f, 0.f}, vb = va;
        if (n < 128) { const int p = n & 63; const float a_r = Apr[(15 - s) * 64 + p], a_i = Api[(15 - s) * 64 + p];
            const LAS f32x4* br = (const LAS f32x4*)(Bbr + p * 16 + hi0); const LAS f32x4* bi = (const LAS f32x4*)(Bbi + p * 16 + hi0); const f32x4 br0 = br[0], br1 = br[1], bi0 = bi[0], bi1 = bi[1];
            if (n < 64) { va = br0 * a_r - bi0 * a_i; vb = br1 * a_r - bi1 * a_i; } else { va = bi0 * a_r + br0 * a_i; vb = bi1 * a_r + br1 * a_i; } }
        v4u o; o.x = pk2(va.x, va.y); o.y = pk2(va.z, va.w); o.z = pk2(vb.x, vb.y); o.w = pk2(vb.z, vb.w);
        *(GAS v4u*)(WP + ((size_t)(g * 256 + n)) * 256 + kv * 8) = o; }
    __syncthreads();
}

__device__ const unsigned char T5_BUCKET[128] = {0, 1, 2, 3, 4, 5, 6, 7, 8, 9, 10, 11, 12, 13, 14, 15, 16, 16, 16, 17, 17, 18, 18, 18, 19, 19, 19, 20, 20, 20, 20, 21, 21, 21, 21, 22, 22, 22, 22, 22, 23, 23, 23, 23, 23, 23, 24, 24, 24, 24, 24, 24,
    25, 25, 25, 25, 25, 25, 25, 26, 26, 26, 26, 26, 26, 26, 26, 27, 27, 27, 27, 27, 27, 27, 27, 27, 27, 28, 28, 28, 28, 28, 28, 28, 28, 28, 28, 29, 29, 29, 29, 29, 29, 29, 29, 29, 29, 29, 29, 30, 30, 30, 30, 30, 30, 30, 30, 30, 30, 30, 30, 30, 30,
    31, 31, 31, 31, 31, 31, 31, 31, 31, 31, 31, 31, 31, 31, 31};
constexpr int AT_KS = 0, AT_KSTRIDE = 144, AT_VT = 256 * 144, AT_VSTRIDE = 528, AT_BT = AT_VT + 64 * 528;
constexpr float NEGBIG = -1e30f;
__device__ __forceinline__ void attn_unit(LAS unsigned char* lds, int b, int nb, int kvh, const bf16* Qb, const bf16* KV, const float* btab, const float* sinks, bf16* ATT, float* RSA, int tid, int lane, int wave) {
    const int head = kvh * 8 + wave;
    for (int i = tid; i < 8 * 192; i += 512) { const int w = i / 192, n = (i - w * 192) - 32; float v = NEGBIG; if (n >= 0 && n < 128) v = btab[(int)T5_BUCKET[n] * 16 + kvh * 8 + w] * LOG2E; ((LAS float*)(lds + AT_BT))[i] = v; }
    const long tok0 = (long)b * SEQ + (long)nb * 128 - 128;
#pragma unroll
    for (int i = 0; i < 4; ++i) { const int idx = tid + 512 * i, row = idx >> 3, ch = idx & 7;
        if (nb > 0 || row >= 128) {
            const bf16* src = KV + (tok0 + row) * 256 + kvh * 64 + ch * 8;
            const v4u kv = *(const GAS v4u*)src; const v4u vv = *(const GAS v4u*)(src + 128);
            *(LAS v4u*)(lds + AT_KS + row * AT_KSTRIDE + ch * 16) = kv;
            const int pos = (row & ~12) | ((row & 4) << 1) | ((row & 8) >> 1);
            LAS bf16* vt = (LAS bf16*)(lds + AT_VT) + (ch * 8) * 264 + pos;
            vt[0 * 264] = (bf16)(vv.x & 0xffffu); vt[1 * 264] = (bf16)(vv.x >> 16); vt[2 * 264] = (bf16)(vv.y & 0xffffu); vt[3 * 264] = (bf16)(vv.y >> 16);
            vt[4 * 264] = (bf16)(vv.z & 0xffffu); vt[5 * 264] = (bf16)(vv.z >> 16); vt[6 * 264] = (bf16)(vv.w & 0xffffu); vt[7 * 264] = (bf16)(vv.w >> 16);
        } }
    __syncthreads();
    const int r = lane & 31, h = lane >> 5;
    const float sinkL2 = sinks[head] * LOG2E;
    const LAS float* bt = (const LAS float*)(lds + AT_BT) + wave * 192 + 32 + (r - 4 * h);
    for (int j = 0; j < 4; ++j) {
        const long qrow = (long)b * SEQ + nb * 128 + 32 * j + r;
        bf16x8 qf[4];
#pragma unroll
        for (int ds = 0; ds < 4; ++ds) qf[ds] = *(const GAS bf16x8*)(Qb + qrow * 1024 + head * 64 + 16 * ds + 8 * h);
        f32x16 S[5];
#pragma unroll
        for (int c = 0; c < 5; ++c) { const int kt = j + c; const bool valid = (nb > 0) || (kt >= 4);
            f32x16 a;
#pragma unroll
            for (int reg = 0; reg < 16; ++reg) a[reg] = 0.f;
            if (valid) {
#pragma unroll
                for (int ds = 0; ds < 4; ++ds) { const bf16x8 kf = *(const LAS bf16x8*)(lds + AT_KS + (32 * kt + r) * AT_KSTRIDE + (16 * ds + 8 * h) * 2); a = __builtin_amdgcn_mfma_f32_32x32x16_bf16(kf, qf[ds], a, 0, 0, 0); }
#pragma unroll
                for (int reg = 0; reg < 16; ++reg) a[reg] += bt[128 - 32 * c - ((reg & 3) + 8 * (reg >> 2))];
            } else {
#pragma unroll
                for (int reg = 0; reg < 16; ++reg) a[reg] = NEGBIG;
            }
            S[c] = a; }
        float mx = sinkL2;
#pragma unroll
        for (int c = 0; c < 5; ++c)
#pragma unroll
            for (int reg = 0; reg < 16; ++reg) mx = fmaxf(mx, S[c][reg]);
        mx = fmaxf(mx, __shfl_xor(mx, 32));
        float l = 0.f;
#pragma unroll
        for (int c = 0; c < 5; ++c)
#pragma unroll
            for (int reg = 0; reg < 16; ++reg) { const float p = __builtin_amdgcn_exp2f(S[c][reg] - mx); S[c][reg] = p; l += p; }
        l += __shfl_xor(l, 32); l += __builtin_amdgcn_exp2f(sinkL2 - mx);
        f32x16 o0, o1;
#pragma unroll
        for (int reg = 0; reg < 16; ++reg) { o0[reg] = 0.f; o1[reg] = 0.f; }
#pragma unroll
        for (int c = 0; c < 5; ++c) { const int kt = j + c; const bool valid = (nb > 0) || (kt >= 4);
            if (valid) {
#pragma unroll
                for (int s2 = 0; s2 < 2; ++s2) { v4u pw; pw.x = pg8::cvt_pk_bf16(S[c][8 * s2 + 0], S[c][8 * s2 + 1]); pw.y = pg8::cvt_pk_bf16(S[c][8 * s2 + 2], S[c][8 * s2 + 3]);
                    pw.z = pg8::cvt_pk_bf16(S[c][8 * s2 + 4], S[c][8 * s2 + 5]); pw.w = pg8::cvt_pk_bf16(S[c][8 * s2 + 6], S[c][8 * s2 + 7]);
                    const bf16x8 pf = __builtin_bit_cast(bf16x8, pw);
                    const bf16x8 v0 = *(const LAS bf16x8*)(lds + AT_VT + r * AT_VSTRIDE + (32 * kt + 16 * s2 + 8 * h) * 2);
                    const bf16x8 v1 = *(const LAS bf16x8*)(lds + AT_VT + (32 + r) * AT_VSTRIDE + (32 * kt + 16 * s2 + 8 * h) * 2);
                    o0 = __builtin_amdgcn_mfma_f32_32x32x16_bf16(v0, pf, o0, 0, 0, 0); o1 = __builtin_amdgcn_mfma_f32_32x32x16_bf16(v1, pf, o1, 0, 0, 0); }
            } }
        const float inv = 1.0f / l; float ss = 0.f;
        bf16* orow = ATT + qrow * 2048 + head * 64 + 4 * h;
#pragma unroll
        for (int g4 = 0; g4 < 4; ++g4) { const float a0 = o0[4 * g4] * inv, a1 = o0[4 * g4 + 1] * inv, a2 = o0[4 * g4 + 2] * inv, a3 = o0[4 * g4 + 3] * inv;
            const float c0 = o1[4 * g4] * inv, c1 = o1[4 * g4 + 1] * inv, c2 = o1[4 * g4 + 2] * inv, c3 = o1[4 * g4 + 3] * inv;
            ss += (a0 * a0 + a1 * a1) + (a2 * a2 + a3 * a3) + (c0 * c0 + c1 * c1) + (c2 * c2 + c3 * c3);
            v2u w0; w0.x = pg8::cvt_pk_bf16(a0, a1); w0.y = pg8::cvt_pk_bf16(a2, a3); v2u w1; w1.x = pg8::cvt_pk_bf16(c0, c1); w1.y = pg8::cvt_pk_bf16(c2, c3);
            *(GAS v2u*)(orow + 8 * g4) = w0; *(GAS v2u*)(orow + 32 + 8 * g4) = w1; }
        ss += __shfl_xor(ss, 32);
        if (h == 0) RSA[qrow * 16 + head] = ss;
    }
    __syncthreads();
}


__device__ __forceinline__ void ssm_carry(LAS unsigned char* lds, int L, const float* A16, const float* Sst, bf16* UX, int wave, int lane) {
    const int g = L >> 2, p = lane;
    const float a_r = A16[(g * 64 + p) * 2], a_i = A16[(g * 64 + p) * 2 + 1];
    const float* Sp = Sst + ((size_t)L * 256 + wave * 32) * 128 + p;
    float sr[32], si[32];
#pragma unroll
    for (int c = 0; c < 32; ++c) { sr[c] = Sp[(size_t)c * 128]; si[c] = Sp[(size_t)c * 128 + 64]; }
    float xr = 0.f, xi = 0.f;
#pragma unroll
    for (int c = 0; c < 32; ++c) { const float nr = a_r * xr - a_i * xi + sr[c], ni = a_r * xi + a_i * xr + si[c]; xr = nr; xi = ni; }
    LAS float* se = (LAS float*)lds;
    se[(wave * 64 + p) * 2] = xr; se[(wave * 64 + p) * 2 + 1] = xi;
    float br = a_r, bi = a_i;
#pragma unroll
    for (int k = 0; k < 5; ++k) { const float t = br * br - bi * bi; bi = 2.f * br * bi; br = t; }
    __syncthreads();
    float cr = 0.f, ci = 0.f;
    for (int v = 0; v < 7; ++v) if (v < wave) { const float er = se[(v * 64 + p) * 2], ei = se[(v * 64 + p) * 2 + 1]; const float nr = br * cr - bi * ci + er, ni = br * ci + bi * cr + ei; cr = nr; ci = ni; }
    bf16* Xp = UX + ((size_t)L * 256 + wave * 32) * 384 + 256 + p;
    xr = cr; xi = ci;
#pragma unroll
    for (int c = 0; c < 32; ++c) { Xp[(size_t)c * 384] = (bf16)f2bf(xr); Xp[(size_t)c * 384 + 64] = (bf16)f2bf(xi);
        const float nr = a_r * xr - a_i * xi + sr[c], ni = a_r * xi + a_i * xr + si[c]; xr = nr; xi = ni; }
}

constexpr int RT_ROWB = 528, RT_BUF = 96 * RT_ROWB, RT_LG = 2 * RT_BUF;
__device__ __forceinline__ void route_phase(LAS unsigned char* lds, int R0, const bf16* TB, const bf16* WrH, const bf16* WrL, const float* brg, const float* bre, gu32* ctl, unsigned* rec, unsigned* etok, float* ew, float* ers, int tid, int lane, int wave) {
    const int r = lane & 15, kq = lane >> 4;
    v4u st[6];
#define RT_LOAD(k0) do { _Pragma("unroll") for (int j = 0; j < 6; ++j) { const int q = tid + 512 * j, row96 = q >> 5, pc = q & 31; const bf16* src = (row96 < 48 ? WrH + (size_t)row96 * D : WrL + (size_t)(row96 - 48) * D) + (k0) + pc * 8; st[j] = *(const GAS v4u*)src; } } while (0)
#define RT_STORE(buf) do { _Pragma("unroll") for (int j = 0; j < 6; ++j) { const int q = tid + 512 * j, row96 = q >> 5, pc = q & 31; *(LAS v4u*)(lds + (buf) * RT_BUF + row96 * RT_ROWB + pc * 16) = st[j]; } } while (0)
    f32x4 acc[3];
#pragma unroll
    for (int cb = 0; cb < 3; ++cb) acc[cb] = (f32x4){0.f, 0.f, 0.f, 0.f};
    float ss = 0.f;
    const bf16* tp = TB + (size_t)(R0 + (wave & 3) * 16 + r) * D + kq * 8;
    v4u a_cur[8], a_nxt[8];
    RT_LOAD(0);
    if (wave < 4) {
#pragma unroll
        for (int ks = 0; ks < 8; ++ks) a_cur[ks] = *(const GAS v4u*)(tp + ks * 32);
    }
    RT_STORE(0);
    __syncthreads();
    for (int s = 0; s < 8; ++s) {
        if (s < 7) { RT_LOAD((s + 1) * 256);
            if (wave < 4) {
#pragma unroll
                for (int ks = 0; ks < 8; ++ks) a_nxt[ks] = *(const GAS v4u*)(tp + (s + 1) * 256 + ks * 32);
            } }
        if (wave < 4) { const LAS unsigned char* bb = lds + (s & 1) * RT_BUF + r * RT_ROWB + kq * 16;
#pragma unroll
            for (int ks = 0; ks < 8; ++ks) { const v4u aw = a_cur[ks]; const bf16x8 af = __builtin_bit_cast(bf16x8, aw);
                { const float e0 = pg8::bf_lo(aw.x), e1 = pg8::bf_hi(aw.x), e2 = pg8::bf_lo(aw.y), e3 = pg8::bf_hi(aw.y), e4 = pg8::bf_lo(aw.z), e5 = pg8::bf_hi(aw.z), e6 = pg8::bf_lo(aw.w), e7 = pg8::bf_hi(aw.w);
                  ss += (e0 * e0 + e1 * e1) + (e2 * e2 + e3 * e3) + (e4 * e4 + e5 * e5) + (e6 * e6 + e7 * e7); }
#pragma unroll
                for (int cb = 0; cb < 3; ++cb) { const bf16x8 bh = *(const LAS bf16x8*)(bb + (cb * 16) * RT_ROWB + ks * 64), bl = *(const LAS bf16x8*)(bb + (48 + cb * 16) * RT_ROWB + ks * 64);
                    acc[cb] = __builtin_amdgcn_mfma_f32_16x16x32_bf16(af, bh, acc[cb], 0, 0, 0); acc[cb] = __builtin_amdgcn_mfma_f32_16x16x32_bf16(af, bl, acc[cb], 0, 0, 0); } }
#pragma unroll
            for (int ks = 0; ks < 8; ++ks) a_cur[ks] = a_nxt[ks];
        }
        if (s < 7) RT_STORE((s + 1) & 1);
        __syncthreads();
    }
#undef RT_LOAD
#undef RT_STORE
    if (wave < 4) {
        ss += __shfl_xor(ss, 16); ss += __shfl_xor(ss, 32);
        LAS float* lg = (LAS float*)(lds + RT_LG) + wave * (16 * 48);
#pragma unroll
        for (int cb = 0; cb < 3; ++cb)
#pragma unroll
            for (int reg = 0; reg < 4; ++reg) lg[(kq * 4 + reg) * 48 + cb * 16 + r] = acc[cb][reg];
        LDS_WAIT(); asm volatile("" ::: "memory");
        if (lane < 16) { const int row = lane, token = R0 + wave * 16 + row; const float rstd = 1.f / sqrtf(ss * (1.f / D) + EPS); const LAS float* lr = lg + row * 48;
            float gl[4]; float gmax = -3.4e38f; int gi = 0;
#pragma unroll
            for (int j = 0; j < 4; ++j) { gl[j] = lr[j] * rstd + brg[j]; if (gl[j] > gmax) { gmax = gl[j]; gi = j; } }
            float gsum = 0.f;
#pragma unroll
            for (int j = 0; j < 4; ++j) gsum += __expf(gl[j] - gmax);
            const float gate = 1.f / gsum;
            float v0 = -3.4e38f, v1 = -3.4e38f; int i0 = 0, i1 = 0;
#pragma unroll
            for (int e = 0; e < 8; ++e) { const float v = lr[4 + gi * 8 + e] * rstd + bre[gi * 8 + e];
                if (v > v0) { v1 = v0; i1 = i0; v0 = v; i0 = e; } else if (v > v1) { v1 = v; i1 = e; } }
            const float w0 = gate / (1.f + __expf(v1 - v0)), w1 = gate - w0;
            const int E0 = gi * 8 + i0, E1 = gi * 8 + i1;
            const unsigned p0 = __hip_atomic_fetch_add(ctl + CW_CNT + 64 * E0, 1u, RLX_AGENT), p1 = __hip_atomic_fetch_add(ctl + CW_CNT + 64 * E1, 1u, RLX_AGENT);
            v4u a; a.x = (unsigned)E0; a.y = p0; a.z = (unsigned)E1; a.w = p1; *(GAS v4u*)(rec + (size_t)token * 4) = a;
            const unsigned i0x = (unsigned)E0 * 16384u + p0, i1x = (unsigned)E1 * 16384u + p1;
            etok[i0x] = (unsigned)token; etok[i1x] = (unsigned)token; ew[i0x] = w0; ew[i1x] = w1; ers[i0x] = rstd; ers[i1x] = rstd;
        }
    }
    __syncthreads();
}

struct Args { const float* in[27]; float* out; unsigned char* ws; };
#ifndef DUP_MASK
#define DUP_MASK 0
#endif
#ifndef PROBE_PH
#define PROBE_PH -1
#endif
#define PROBE_T0(k) do { if (PROBE_PH == (k) && blockIdx.x == 0 && F.wave == 0) { const unsigned long long t_ = __builtin_amdgcn_s_memrealtime(); if (pg8::lane_id_() == 0) { F.MISC[16] = (unsigned)t_; F.MISC[17] = (unsigned)(t_ >> 32); } } } while (0)
#define PROBE_T1(k) do { if (PROBE_PH == (k) && blockIdx.x == 0 && F.wave == 0) { const unsigned long long t_ = __builtin_amdgcn_s_memrealtime(); if (pg8::lane_id_() == 0) { F.MISC[18] = (unsigned)t_; F.MISC[19] = (unsigned)(t_ >> 32); } } } while (0)
typedef __attribute__((address_space(4))) const char* kargp_t;
__device__ __forceinline__ const void* karg(int k) { kargp_t p = (kargp_t)__builtin_amdgcn_kernarg_segment_ptr(); asm volatile("" : "+s"(p)); return *(const void* const __attribute__((address_space(4)))*)(p + 8 * k); }
#define KIN(k) ((const float*)karg(k))
#define KOUT() ((float*)karg(27))
#define KWS(T, off) ((T*)((unsigned char*)karg(28) + (off)))
#define IDS() int tid = F.wave * 64 + pg8::lane_id_(); asm volatile("" : "+v"(tid)); const int lane = tid & 63; (void)lane
#define SHQ_BEGIN(qh_, R_, exl_) { int sh_ = (int)blockIdx.x & 7, tried_ = 0; unsigned qn_ = 0; if (lane == 0) qn_ = __hip_atomic_fetch_add((qh_) + 64 * sh_, 1u, RLX_AGENT); \
    for (;;) { int tk_ = __builtin_amdgcn_readfirstlane((int)qn_); \
        while (tk_ >= (R_)) { (exl_)[sh_] = 1u; do { ++tried_; sh_ = (sh_ + 1) & 7; } while (tried_ < 8 && (exl_)[sh_] != 0u); if (tried_ >= 8) break; \
            if (lane == 0) qn_ = __hip_atomic_fetch_add((qh_) + 64 * sh_, 1u, RLX_AGENT); tk_ = __builtin_amdgcn_readfirstlane((int)qn_); } \
        if (tried_ >= 8) break; const int chunk = sh_ * (R_) + tk_; if (lane == 0) qn_ = __hip_atomic_fetch_add((qh_) + 64 * sh_, 1u, RLX_AGENT);
#define SHQ_END } }
__global__ void __launch_bounds__(NWAVES * 64, 2) hymba_fwd(Args args_unused) {
    extern __shared__ __attribute__((aligned(16))) unsigned char lds[];
    Frame F;
    F.lds = (LAS unsigned char*)lds;
    F.MISC = (volatile LAS unsigned*)(F.lds + MISC_OFF);
    F.wave = __builtin_amdgcn_readfirstlane((int)threadIdx.x >> 6);
    F.G = gridDim.x; { const int bx = blockIdx.x; F.vcu = (F.G % 8 == 0) ? (bx % 8) * (F.G / 8) + bx / 8 : bx; }
    F.ctl = (gu32*)KWS(unsigned char, WS_CTL);
    for (int u = threadIdx.x; u < (LDS_BYTES - LDSCTL_OFF) / 4; u += NWAVES * 64) ((LAS unsigned*)(F.lds + LDSCTL_OFF))[u] = 0u;
    __syncthreads();
    (void)xcd_barrier_post((unsigned*)(F.ctl + CW_BAR), F.MISC + 8, threadIdx.x == 0);
#define GRID_BAR() do { XcdBarrier b_; b_.bar = (unsigned*)KWS(unsigned, WS_CTL) + CW_BAR; b_.x = xb_xcc_id(); b_.st = F.MISC + 8; xcd_barrier(b_, F.wave == 0 && pg8::lane_id_() == 0); } while (0)
    const int gw = F.vcu * NWAVES + F.wave, NGW = F.G * NWAVES;
    LAS int* tbl = (LAS int*)(F.lds + TB_OFF);

    PROBE_T0(0);
#if (DUP_MASK >> 0) & 1
_Pragma("unroll") for (int rep_ = 0; rep_ < 2; ++rep_)
#else
    constexpr int rep_ = 0;
#endif
    {
        IDS();
        p0_ssm_tables(F, F.vcu >> 2, F.vcu & 3, KIN(5), KIN(6), KIN(7), KIN(8), KIN(9), KIN(10), KIN(11), KIN(12), KWS(bf16, WS_TE), KWS(bf16, WS_WP), KWS(float, WS_SMALL + SM_A16));
        { const float* g_ffn = KIN(18); const float* wrg = KIN(19); const float* wre = KIN(21); bf16* WrH = KWS(bf16, WS_SMALL + SM_WRH); bf16* WrL = KWS(bf16, WS_SMALL + SM_WRL);
          const int gtid = F.vcu * 512 + tid, NGT = F.G * 512;
          if (gtid < D) { KWS(float, WS_SMALL + SM_ONES)[gtid] = 1.0f; KWS(float, WS_SMALL + SM_GCAT)[gtid] = gtid < DATT ? KIN(15)[gtid] : KIN(16)[gtid - DATT]; }
          for (int e = gtid; e < NRT * D; e += NGT) { const int j = e / D, k = e - j * D; float w = 0.f;
            if (j < 4) w = wrg[k * 4 + j]; else if (j < 36) w = wre[((size_t)((j - 4) >> 3) * D + k) * 8 + ((j - 4) & 7)];
            w *= g_ffn[k]; const unsigned hi = f2bf(w); WrH[e] = (bf16)hi; WrL[e] = (bf16)f2bf(w - bf2f(hi)); } }
        { LAS float* scr = (LAS float*)(F.lds + RING_OFF + F.wave * 16384);
          constexpr int IT_WIN = 32 * 72, CH0 = 4, NQ0 = IT_WIN / CH0 + M_TOK / CH0;
          const float* w_in = KIN(3); const float* x = KIN(0); const float* g_mix = KIN(2); unsigned char* ws = KWS(unsigned char, 0);
          f32x4 gmv[8];
#pragma unroll
          for (int j = 0; j < 8; ++j) gmv[j] = ((const GAS f32x4*)g_mix)[lane + 64 * j];
          gu32* qh = F.ctl + CW_Q0 + 512 * rep_; volatile LAS unsigned* exl = F.MISC + 20 + 8 * rep_;
          static_assert(NQ0 % 8 == 0, "shards");
          SHQ_BEGIN(qh, NQ0 / 8, exl)
            const int q = chunk;
            if (q < IT_WIN / CH0) { f32x4 rgA[8], rgB[8], scA[2], scB[2]; TItem tA, tB; tA.W = w_in; tA.N = NPROJ; tA.WT = (bf16*)(ws + WS_WIN); tA.ldk = D; tA.ks = nullptr; tB = tA;
#pragma unroll
                for (int i = 0; i < CH0; i += 2) { const int r0 = q * CH0 + i, r1 = r0 + 1; const int kb0 = r0 / 72, nb0 = r0 - kb0 * 72, kb1 = r1 / 72, nb1 = r1 - kb1 * 72;
                    tA.drow0 = (size_t)32 * nb0; tA.k0 = 64 * kb0; tA.n0 = 32 * nb0; tB.drow0 = (size_t)32 * nb1; tB.k0 = 64 * kb1; tB.n0 = 32 * nb1;
                    titem_load<false, false>(rgA, scA, tA, lane); titem_load<false, false>(rgB, scB, tB, lane); titem_finish<false>(rgA, scA, tA, scr, lane); titem_finish<false>(rgB, scB, tB, scr, lane); } }
            else { const int m = CH0 * (q - IT_WIN / CH0);
#pragma unroll
                for (int i = 0; i < CH0; i += 2) rms_rows2_to_bf16(x + (size_t)(m + i) * D, gmv, (bf16*)(ws + WS_XN) + (size_t)(m + i) * D, lane); }
          SHQ_END }
        GRID_BAR();
    }
    PROBE_T1(0);
    PROBE_T0(1);
#if ((DUP_MASK >> 1) & 1) || ((DUP_MASK >> 4) & 1) || ((DUP_MASK >> 5) & 1)
_Pragma("unroll") for (int rep1_ = 0; rep1_ < 2; ++rep1_)
#else
    constexpr int rep1_ = 0;
#endif
    {
        IDS();
        const bool gemm_cu = blockIdx.x < 144;
        if (gemm_cu && !(((DUP_MASK >> 4) & 1) && rep1_ == 1)) {
            unsigned char* ws = KWS(unsigned char, 0);
            pg8::StaticOrder S; S.init(M_TOK, NPROJ, 144, (int)blockIdx.x);
            pg8::EpiInProj E{(bf16*)(ws + WS_Q), (bf16*)(ws + WS_KV), (bf16*)(ws + WS_UX)};
            pg8::gemm_phase<pg8::EpiInProj, pg8::StaticOrder, D, D, D>(F.lds + RING_OFF, F.wave, (const bf16*)(ws + WS_XN), (const bf16*)(ws + WS_WIN), S, E);
        }
        if (!((((DUP_MASK >> 4) & 1) || ((DUP_MASK >> 5) & 1)) && rep1_ == 1 && gemm_cu))
        { LAS float* scr = (LAS float*)(F.lds + RING_OFF + F.wave * 16384);
          const float* w_glu = KIN(13); const float* w_out = KIN(17); const float* g_ffn = KIN(18); const float* w_gate = KIN(23); const float* w_up = KIN(24); const float* w_down = KIN(25);
          unsigned char* ws = KWS(unsigned char, 0); const float* ones = (const float*)(ws + WS_SMALL + SM_ONES); const float* gcat = (const float*)(ws + WS_SMALL + SM_GCAT);
          gu32* qh = F.ctl + CW_Q1 + 512 * rep1_; volatile LAS unsigned* exl = F.MISC + 36 + 8 * rep1_;
          constexpr int CH = 8;
          static_assert(NQ1 % (8 * CH) == 0, "shards");
          SHQ_BEGIN(qh, NQ1 / CH / 8, exl)
            const int q0 = chunk * CH;
            f32x4 rgA[8], rgB[8], scA[2], scB[2]; TItem tA = decode_q1(q0, ones, gcat, w_glu, w_out, g_ffn, w_gate, w_up, w_down, ws), tB; titem_load<true, true>(rgA, scA, tA, lane);
#pragma unroll
            for (int i = 0; i < CH; i += 2) { tB = decode_q1(q0 + i + 1, ones, gcat, w_glu, w_out, g_ffn, w_gate, w_up, w_down, ws); titem_load<true, true>(rgB, scB, tB, lane); titem_finish<true>(rgA, scA, tA, scr, lane);
                if (i + 2 < CH) { tA = decode_q1(q0 + i + 2, ones, gcat, w_glu, w_out, g_ffn, w_gate, w_up, w_down, ws); titem_load<true, true>(rgA, scA, tA, lane); } titem_finish<true>(rgB, scB, tB, scr, lane); }
          SHQ_END }
        GRID_BAR();
    }
    PROBE_T1(1);
    PROBE_T0(2);
    {
        const int L = (int)blockIdx.x;
#if (DUP_MASK >> 2) & 1
_Pragma("unroll") for (int rep_ = 0; rep_ < 2; ++rep_)
#endif
        {
        { unsigned char* ws = KWS(unsigned char, 0); pg8::OneUnit S{L, L >> 2}; pg8::EpiS E{(float*)(ws + WS_S)};
          pg8::gemm_phase<pg8::EpiS, pg8::OneUnit, 256, 384, 256>(F.lds + RING_OFF, F.wave, (const bf16*)(ws + WS_UX), (const bf16*)(ws + WS_WP), S, E); }
        { int l2 = pg8::lane_id_(); asm volatile("" : "+v"(l2)); unsigned char* ws = KWS(unsigned char, 0); ssm_carry(F.lds + RING_OFF, L, (const float*)(ws + WS_SMALL + SM_A16), (const float*)(ws + WS_S), (bf16*)(ws + WS_UX), F.wave, l2); }
        VM_WAIT(); __syncthreads();
        { unsigned char* ws = KWS(unsigned char, 0); pg8::OneUnit S{L, L >> 2}; pg8::EpiY E{(bf16*)(ws + WS_YG)};
          pg8::gemm_phase<pg8::EpiY, pg8::OneUnit, 384, 384, 384>(F.lds + RING_OFF, F.wave, (const bf16*)(ws + WS_UX), (const bf16*)(ws + WS_TE), S, E); }
        }
#if (DUP_MASK >> 3) & 1
_Pragma("unroll") for (int rep_ = 0; rep_ < 2; ++rep_)
#endif
        { int t2 = F.wave * 64 + pg8::lane_id_(); asm volatile("" : "+v"(t2)); unsigned char* ws = KWS(unsigned char, 0); const float* rel_bias = KIN(1); const float* sinks = KIN(4);
          attn_unit(F.lds + RING_OFF, L >> 6, (L >> 1) & 31, L & 1, (const bf16*)(ws + WS_Q), (const bf16*)(ws + WS_KV), rel_bias, sinks, (bf16*)(ws + WS_MIX), (float*)(ws + WS_RSA), t2, t2 & 63, F.wave); }
        GRID_BAR();
    }
    PROBE_T1(2);
    PROBE_T0(5);
#if (DUP_MASK >> 5) & 1
_Pragma("unroll") for (int rep_ = 0; rep_ < 2; ++rep_)
#endif
    {
        IDS();
        unsigned char* ws = KWS(unsigned char, 0);
        pg8::StaticOrder S; S.init(M_TOK, DSSM, F.G, (int)blockIdx.x);
        pg8::EpiGLU E{(const bf16*)(ws + WS_YG), KIN(14), (bf16*)(ws + WS_MIX), (float*)(ws + WS_RSS)};
        pg8::gemm_phase<pg8::EpiGLU, pg8::StaticOrder, DSSM, DSSM, DSSM>(F.lds + RING_OFF, F.wave, (const bf16*)(ws + WS_YG), (const bf16*)(ws + WS_WGLU), S, E);
        GRID_BAR();
    }
    PROBE_T1(5);
    PROBE_T0(7);
#if (DUP_MASK >> 7) & 1
_Pragma("unroll") for (int rep_ = 0; rep_ < 2; ++rep_)
#endif
    {
        IDS();
        unsigned char* ws = KWS(unsigned char, 0);
        pg8::StaticOrder S; S.init(M_TOK, D, F.G, (int)blockIdx.x);
        LAS pg8::f32x2* sct = (LAS pg8::f32x2*)(F.lds + SC_OFF);
        { const float* RSA = (const float*)(ws + WS_RSA); const float* RSS = (const float*)(ws + WS_RSS);
          for (int j = 0; j < 2; ++j) { pg8::Unit u; if (!S.next(j, u)) break;
              if (tid < 256) { const int row = u.pm * 256 + tid; const GAS f32x4* pa = (const GAS f32x4*)(RSA + (size_t)row * 16); const GAS f32x4* ps = (const GAS f32x4*)(RSS + (size_t)row * 16);
                  const f32x4 a0 = pa[0], a1 = pa[1], a2 = pa[2], a3 = pa[3], s0 = ps[0], s1 = ps[1], s2 = ps[2], s3 = ps[3];
                  const float sa = ((a0.x + a0.y) + (a0.z + a0.w)) + ((a1.x + a1.y) + (a1.z + a1.w)) + ((a2.x + a2.y) + (a2.z + a2.w)) + ((a3.x + a3.y) + (a3.z + a3.w));
                  const float ss = ((s0.x + s0.y) + (s0.z + s0.w)) + ((s1.x + s1.y) + (s1.z + s1.w)) + ((s2.x + s2.y) + (s2.z + s2.w)) + ((s3.x + s3.y) + (s3.z + s3.w));
                  const float ra = 1.f / sqrtf(sa * (1.f / DATT) + EPS), rs = 1.f / sqrtf(ss * (1.f / DSSM) + EPS);
                  sct[j * 256 + tid] = (pg8::f32x2){ra / rs, rs}; } }
          __syncthreads(); }
        pg8::EpiXmid E{KIN(0), (bf16*)(ws + WS_TB), sct};
        pg8::gemm_phase<pg8::EpiXmid, pg8::StaticOrder, D, D, D>(F.lds + RING_OFF, F.wave, (const bf16*)(ws + WS_MIX), (const bf16*)(ws + WS_WOUT), S, E);
        GRID_BAR();
    }
    PROBE_T1(7);
    PROBE_T0(8);
#if (DUP_MASK >> 8) & 1
_Pragma("unroll") for (int rep8_ = 0; rep8_ < 2; ++rep8_)
#else
    constexpr int rep8_ = 1;
#endif
    {
        IDS();
        unsigned char* ws = KWS(unsigned char, 0); const float* brg = KIN(20); const float* bre = KIN(22);
        const size_t doff = rep8_ ? 0 : (WS_O - WS_ROUTE);
        for (int blk = blockIdx.x; blk < M_TOK / 64; blk += F.G) route_phase(F.lds + RING_OFF, blk * 64, (const bf16*)(ws + WS_TB), (const bf16*)(ws + WS_SMALL + SM_WRH), (const bf16*)(ws + WS_SMALL + SM_WRL), brg, bre, F.ctl + (rep8_ ? 0 : 4096),
            (unsigned*)(ws + WS_ROUTE + doff + RT_REC), (unsigned*)(ws + WS_ROUTE + doff + RT_ETOK), (float*)(ws + WS_ROUTE + doff + RT_EW), (float*)(ws + WS_ROUTE + doff + RT_ERS), tid, lane, F.wave);
        GRID_BAR();
    }
    PROBE_T1(8);
    PROBE_T0(10);
    {
        IDS();
        if (tid == 0) { int acc = 0; for (int e = 0; e < 32; ++e) { tbl[e] = acc; acc += (int)((__hip_atomic_load(F.ctl + CW_CNT + 64 * e, RLX_AGENT) + 255u) >> 8); } tbl[32] = acc; }
        __syncthreads();
        LAS int* gidx = (LAS int*)(F.lds + GIDX_OFF);
        { const unsigned* ETOK = KWS(unsigned, WS_ROUTE + RT_ETOK); pg8::MoeOrder S{tbl, 4, F.G, (int)blockIdx.x};
          for (int j = 0; j < 8; ++j) { pg8::Unit u; if (!S.next(j, u)) break; const int Ex = u.pn >> 2, mt = u.pm - tbl[Ex]; const int cntE = (int)__hip_atomic_load(F.ctl + CW_CNT + 64 * Ex, RLX_AGENT);
              if (tid < 256) { const int pos = mt * 256 + tid; gidx[j * 256 + tid] = pos < cntE ? (int)ETOK[(size_t)Ex * 16384 + pos] : 0; } }
          __syncthreads(); }
#if (DUP_MASK >> 10) & 1
_Pragma("unroll") for (int rep_ = 0; rep_ < 2; ++rep_)
#endif
        {
        IDS();
        unsigned char* ws = KWS(unsigned char, 0);
        pg8::MoeOrder S{tbl, 4, F.G, (int)blockIdx.x};
        pg8::EpiSwiGLU E{(const float*)(ws + WS_ROUTE + RT_ERS), (const float*)(ws + WS_ROUTE + RT_EW), (bf16*)(ws + WS_HID), tbl};
        pg8::gemm_phase<pg8::EpiSwiGLU, pg8::MoeOrder, D, D, D, true>(F.lds + RING_OFF, F.wave, (const bf16*)(ws + WS_TB), (const bf16*)(ws + WS_WGU), S, E, gidx);
        GRID_BAR();
        }
    }
    PROBE_T1(10);
    PROBE_T0(11);
#if (DUP_MASK >> 11) & 1
_Pragma("unroll") for (int rep_ = 0; rep_ < 2; ++rep_)
#endif
    {
        IDS();
        unsigned char* ws = KWS(unsigned char, 0);
        pg8::MoeOrder S{tbl, 8, F.G, (int)blockIdx.x}; pg8::EpiDown E{(bf16*)(ws + WS_O)};
        pg8::gemm_phase<pg8::EpiDown, pg8::MoeOrder, DFF, DFF, DFF>(F.lds + RING_OFF, F.wave, (const bf16*)(ws + WS_HID), (const bf16*)(ws + WS_WD), S, E);
        GRID_BAR();
    }
    PROBE_T1(11);
    PROBE_T0(12);
#if (DUP_MASK >> 12) & 1
_Pragma("unroll") for (int rep12_ = 0; rep12_ < 2; ++rep12_)
#endif
    {
        IDS();
        float* outp = KOUT(); const float* g_final = KIN(26);
        unsigned char* ws = KWS(unsigned char, 0); const unsigned* REC = (const unsigned*)(ws + WS_ROUTE + RT_REC); const bf16* OB = (const bf16*)(ws + WS_O); const bf16* TBp = (const bf16*)(ws + WS_TB);
        f32x4 gfv[8];
#pragma unroll
        for (int j = 0; j < 8; ++j) gfv[j] = ((const GAS f32x4*)g_final)[lane + 64 * j];
        for (int m0 = gw; m0 < M_TOK; m0 += 2 * NGW) {
            f32x4 v[2][8]; float s[2];
#pragma unroll
            for (int q = 0; q < 2; ++q) { const int m = m0 + q * NGW;
                const v4u rc = *(const GAS v4u*)(REC + (size_t)m * 4);
                const unsigned s0 = (unsigned)tbl[rc.x] * 256u + rc.y, s1 = (unsigned)tbl[rc.z] * 256u + rc.w;
                const GAS v2u* xr = (const GAS v2u*)(TBp + (size_t)m * D) + lane; const GAS v2u* o0 = (const GAS v2u*)(OB + (size_t)s0 * D) + lane; const GAS v2u* o1 = (const GAS v2u*)(OB + (size_t)s1 * D) + lane;
                s[q] = 0.f;
#pragma unroll
                for (int j = 0; j < 8; ++j) { const v2u xw = xr[64 * j], a = o0[64 * j], c = o1[64 * j];
                    v[q][j].x = pg8::bf_lo(xw.x) + pg8::bf_lo(a.x) + pg8::bf_lo(c.x); v[q][j].y = pg8::bf_hi(xw.x) + pg8::bf_hi(a.x) + pg8::bf_hi(c.x);
                    v[q][j].z = pg8::bf_lo(xw.y) + pg8::bf_lo(a.y) + pg8::bf_lo(c.y); v[q][j].w = pg8::bf_hi(xw.y) + pg8::bf_hi(a.y) + pg8::bf_hi(c.y);
                    s[q] += dot4(v[q][j]); } }
#pragma unroll
            for (int q = 0; q < 2; ++q) { const int m = m0 + q * NGW; const float rstd = 1.f / sqrtf(wave_sum(s[q]) * (1.f / D) + EPS);
                GAS f32x4* orow = (GAS f32x4*)(outp + (size_t)m * D) + lane;
#pragma unroll
                for (int j = 0; j < 8; ++j) orow[64 * j] = v[q][j] * rstd * gfv[j]; }
        }
#if (DUP_MASK >> 12) & 1
        GRID_BAR();
#endif
    }
    PROBE_T1(12);
    if (PROBE_PH >= 0 && blockIdx.x == 0) { __syncthreads(); const unsigned long long t0_ = ((unsigned long long)F.MISC[17] << 32) | F.MISC[16], t1_ = ((unsigned long long)F.MISC[19] << 32) | F.MISC[18];
        const unsigned long long te_ = __builtin_amdgcn_s_memrealtime(), w_ = 4ull * (t1_ - t0_); while (__builtin_amdgcn_s_memrealtime() - te_ < w_) __builtin_amdgcn_s_sleep(32); }
}

extern "C" void kernel_launch(void* const* d_in, const int* in_sizes, int n_in, void* d_out, int out_size, void* d_ws, size_t ws_size, hipStream_t stream) {
    static int grid = 0;
    if (grid == 0) {
        if (n_in != 27 || in_sizes[0] != M_TOK * D || out_size != M_TOK * D || ws_size < WS_END) { fprintf(stderr, "kernel_launch: unexpected shapes (n_in %d, in0 %d, out %d, ws %zu < %zu)\n", n_in, n_in > 0 ? in_sizes[0] : -1, out_size, ws_size, (size_t)WS_END); grid = -1; return; }
        int dev = 0, cus = 0, per_cu = 0;
        if (hipGetDevice(&dev) != hipSuccess || hipDeviceGetAttribute(&cus, hipDeviceAttributeMultiprocessorCount, dev) != hipSuccess) { grid = -1; return; }
        if (hipFuncSetAttribute((const void*)hymba_fwd, hipFuncAttributeMaxDynamicSharedMemorySize, LDS_BYTES) != hipSuccess) { fprintf(stderr, "kernel_launch: hipFuncSetAttribute failed\n"); grid = -1; return; }
        if (hipOccupancyMaxActiveBlocksPerMultiprocessor(&per_cu, (const void*)hymba_fwd, NWAVES * 64, LDS_BYTES) != hipSuccess || per_cu < 1)
            fprintf(stderr, "kernel_launch: note: occupancy query reports %d workgroups per CU\n", per_cu);
        (void)hipGetLastError();
        if (cus != 256) { fprintf(stderr, "kernel_launch: built for a 256-CU device (one workgroup per CU, 256 SSM / attention units), found %d\n", cus); grid = -1; return; }
        grid = cus;
    }
    if (grid < 0) return;
    if (hipMemsetAsync((char*)d_ws + WS_CTL, 0, CTL_ZERO_BYTES, stream) != hipSuccess) return;
    Args a{};
    for (int i = 0; i < 27; ++i) a.in[i] = (const float*)d_in[i];
    a.out = (float*)d_out; a.ws = (unsigned char*)d_ws;
    hipLaunchKernelGGL(hymba_fwd, dim3(grid), dim3(NWAVES * 64), LDS_BYTES, stream, a);
}
```
